# Optimizing an MI355X kernel written in HIP

```python
import math
import jax, jax.numpy as jnp
from jax import lax
import numpy as np

D_MODEL = 1024
BATCH = 2
SEQ = 8192
DEPTH = 2

REL_BUCKETS = 32
REL_MAX_EXACT = 16
REL_MAX_DIST = 128
ATTN_HEADS = 8

GLA_HEADS = 4
GLA_DK = 64
GLA_DV = 128
GLA_RANK = 16
GLA_TAU = 16.0
GLA_CHUNK = 64

SWA_HEADS = ATTN_HEADS
SWA_KV_HEADS = 2
SWA_DH = 64
SWA_WINDOW = 128

MOBA_HEADS = ATTN_HEADS
MOBA_KV_HEADS = 2
MOBA_DH = 128
MOBA_BLOCK = 256
MOBA_TOPK = 3
MOBA_Q_CHUNK = 32

EPS = 1e-6

A_WIDTH = GLA_HEADS * GLA_DV
B_WIDTH = SWA_HEADS * SWA_DH
C_WIDTH = MOBA_HEADS * MOBA_DH
EVEN_WIDTH = A_WIDTH + B_WIDTH
EVEN_SPLITS = (GLA_HEADS * GLA_DK, GLA_HEADS * GLA_DK, A_WIDTH, GLA_RANK, A_WIDTH,
               B_WIDTH, SWA_KV_HEADS * SWA_DH, SWA_KV_HEADS * SWA_DH, B_WIDTH)
EVEN_COLS = 2832
ODD_SPLITS = (C_WIDTH, MOBA_KV_HEADS * MOBA_DH, MOBA_KV_HEADS * MOBA_DH, C_WIDTH)
ODD_COLS = 2560
N_EVEN = (DEPTH + 1) // 2
N_ODD = DEPTH // 2

kernel_name = "hybrid_gla_swa_moba_gated"


def rmsnorm(x, g):
    xf = x.astype(jnp.float32)
    y = xf * lax.rsqrt(jnp.mean(xf * xf, axis=-1, keepdims=True) + EPS)
    return (y * g.astype(jnp.float32)).astype(x.dtype)


def split_cols(h, sizes):
    idx = np.cumsum(np.array(sizes))[:-1].tolist()
    return jnp.split(h, idx, axis=-1)


def t5_bucket(dist):
    n = jnp.maximum(dist, 0)
    nf = jnp.maximum(n, 1).astype(jnp.float32)
    large = REL_MAX_EXACT + (jnp.log(nf / REL_MAX_EXACT) / math.log(REL_MAX_DIST / REL_MAX_EXACT)
                             * (REL_BUCKETS - REL_MAX_EXACT)).astype(jnp.int32)
    large = jnp.minimum(large, REL_BUCKETS - 1)
    return jnp.where(n < REL_MAX_EXACT, n, large)


def gla_chunked(q, k, v, log_a):
    B_, S_, H_, DK = q.shape
    DV = v.shape[-1]
    N = S_ // GLA_CHUNK

    def chunks(t):
        return t.astype(jnp.float32).reshape(B_, N, GLA_CHUNK, H_, t.shape[-1]).transpose(0, 3, 1, 2, 4)

    qc, kc, vc, gc = chunks(q), chunks(k), chunks(v), chunks(log_a)
    b = jnp.cumsum(gc, axis=3)
    b_last = b[:, :, :, -1:, :]
    q_e = qc * jnp.exp(b) * (DK ** -0.5)
    k_e = kc * jnp.exp(-b)
    causal = jnp.tril(jnp.ones((GLA_CHUNK, GLA_CHUNK), dtype=bool))
    att = jnp.where(causal, jnp.einsum('bhncd,bhnsd->bhncs', q_e, k_e), 0.0)
    o_intra = jnp.einsum('bhncs,bhnse->bhnce', att, vc)
    kv_chunk = jnp.einsum('bhncd,bhnce->bhnde', kc * jnp.exp(b_last - b), vc)
    decay = jnp.exp(b_last[:, :, :, 0, :])

    def step(state, inp):
        dec, kv = inp
        return dec[..., None] * state + kv, state

    s0 = jnp.zeros((B_, H_, DK, DV), jnp.float32)
    _, s_before = lax.scan(step, s0, (jnp.moveaxis(decay, 2, 0), jnp.moveaxis(kv_chunk, 2, 0)))
    s_before = jnp.moveaxis(s_before, 0, 2)
    o = o_intra + jnp.einsum('bhncd,bhnde->bhnce', q_e, s_before)
    return o.transpose(0, 2, 3, 1, 4).reshape(B_, S_, H_, DV).astype(v.dtype)


def swa_attention(q, k, v, sinks, rel_bias):
    B_, S_, H_, DH = q.shape
    KVH = k.shape[2]
    G = H_ // KVH
    W = SWA_WINDOW
    NB = S_ // W
    qb = q.reshape(B_, NB, W, KVH, G, DH).transpose(0, 3, 4, 1, 2, 5)

    def band(t):
        tb = t.reshape(B_, NB, W, KVH, DH).transpose(0, 3, 1, 2, 4)
        prev = jnp.pad(tb[:, :, :-1], ((0, 0), (0, 0), (1, 0), (0, 0), (0, 0)))
        return jnp.concatenate([prev, tb], axis=3)

    kb, vb = band(k), band(v)
    qi = jnp.arange(W)[:, None]
    kj = jnp.arange(2 * W)[None, :]
    dist = qi + W - kj
    in_win = (dist >= 0) & (dist < W)
    blk = jnp.arange(NB)[:, None, None]
    mask = in_win[None] & ((blk > 0) | (kj[None] >= W))
    bias = rel_bias[t5_bucket(dist)].astype(jnp.float32)
    bias = bias.transpose(2, 0, 1).reshape(KVH, G, 1, W, 2 * W)
    logits = jnp.einsum('bkgnqd,bknsd->bkgnqs', qb, kb).astype(jnp.float32) * (DH ** -0.5) + bias
    logits = jnp.where(mask, logits, -jnp.inf)
    sink = jnp.broadcast_to(sinks.astype(jnp.float32).reshape(KVH, G, 1, 1, 1), logits.shape[:-1] + (1,))
    probs = jax.nn.softmax(jnp.concatenate([logits, sink], axis=-1), axis=-1)[..., :-1]
    o = jnp.einsum('bkgnqs,bknsd->bkgnqd', probs.astype(v.dtype), vb)
    return o.transpose(0, 3, 4, 1, 2, 5).reshape(B_, S_, H_ * DH)


def moba_attention(q, k, v, rel_bias):
    B_, S_, H_, DH = q.shape
    G = H_ // k.shape[2]
    S_pad = -(-S_ // MOBA_BLOCK) * MOBA_BLOCK
    pad = ((0, 0), (0, S_pad - S_), (0, 0), (0, 0))
    qh = jnp.pad(q, pad).transpose(0, 2, 1, 3)
    kh = jnp.repeat(jnp.pad(k, pad), G, axis=2).transpose(0, 2, 1, 3)
    vh = jnp.repeat(jnp.pad(v, pad), G, axis=2).transpose(0, 2, 1, 3)
    NBLK = S_pad // MOBA_BLOCK
    kblk = kh.reshape(B_, H_, NBLK, MOBA_BLOCK, DH)
    vblk = vh.reshape(B_, H_, NBLK, MOBA_BLOCK, DH)
    kmean = kblk.mean(axis=3)
    k_sel = min(MOBA_TOPK, NBLK)
    bi = jnp.arange(B_)[:, None, None, None]
    hi = jnp.arange(H_)[None, :, None, None]
    offs = jnp.arange(MOBA_BLOCK)
    blk_ids = jnp.arange(NBLK)
    scale = DH ** -0.5

    def one_chunk(c):
        start = c * MOBA_Q_CHUNK
        qc = lax.dynamic_slice_in_dim(qh, start, MOBA_Q_CHUNK, axis=2)
        tpos = start + jnp.arange(MOBA_Q_CHUNK)
        own = start // MOBA_BLOCK
        gate = jnp.einsum('bhqd,bhnd->bhqn', qc, kmean).astype(jnp.float32)
        gate = jnp.where(blk_ids < own, gate, -jnp.inf)
        _, idx = lax.top_k(gate, k_sel)
        kg = kblk[bi, hi, idx].reshape(B_, H_, MOBA_Q_CHUNK, k_sel * MOBA_BLOCK, DH)
        vg = vblk[bi, hi, idx].reshape(B_, H_, MOBA_Q_CHUNK, k_sel * MOBA_BLOCK, DH)
        kpos = (idx[..., None] * MOBA_BLOCK + offs).reshape(B_, H_, MOBA_Q_CHUNK, k_sel * MOBA_BLOCK)
        valid = jnp.broadcast_to((idx < own)[..., None], idx.shape + (MOBA_BLOCK,)).reshape(kpos.shape)
        bias_sel = rel_bias[t5_bucket(tpos[None, None, :, None] - kpos), hi].astype(jnp.float32)
        logit_sel = jnp.einsum('bhqd,bhqsd->bhqs', qc, kg).astype(jnp.float32) * scale + bias_sel
        logit_sel = jnp.where(valid, logit_sel, -jnp.inf)
        ko = lax.dynamic_slice_in_dim(kh, own * MOBA_BLOCK, MOBA_BLOCK, axis=2)
        vo = lax.dynamic_slice_in_dim(vh, own * MOBA_BLOCK, MOBA_BLOCK, axis=2)
        dist_own = tpos[:, None] - (own * MOBA_BLOCK + offs)[None, :]
        bias_own = rel_bias[t5_bucket(dist_own)].astype(jnp.float32).transpose(2, 0, 1)
        logit_own = jnp.einsum('bhqd,bhsd->bhqs', qc, ko).astype(jnp.float32) * scale + bias_own
        logit_own = jnp.where(dist_own >= 0, logit_own, -jnp.inf)
        probs = jax.nn.softmax(jnp.concatenate([logit_sel, logit_own], axis=-1), axis=-1)
        p_sel = probs[..., :k_sel * MOBA_BLOCK]
        p_own = probs[..., k_sel * MOBA_BLOCK:]
        o = jnp.einsum('bhqs,bhqsd->bhqd', p_sel, vg) + jnp.einsum('bhqs,bhsd->bhqd', p_own, vo)
        return o.astype(v.dtype)

    out = lax.map(one_chunk, jnp.arange(S_pad // MOBA_Q_CHUNK))
    out = out.transpose(1, 0, 3, 2, 4).reshape(B_, S_pad, H_ * DH)
    return out[:, :S_]


def even_layer(hn, w_in, gla_w_up, gla_b_up, gla_gain, sinks, w_out, rel_bias):
    B_, S_, _ = hn.shape
    proj = hn @ w_in
    aq, ak, av, a_down, a_gate, bq, bk, bv, b_gate = split_cols(proj, EVEN_SPLITS)
    log_a = jax.nn.log_sigmoid((a_down @ gla_w_up + gla_b_up).astype(jnp.float32)) / GLA_TAU
    oa = gla_chunked(aq.reshape(B_, S_, GLA_HEADS, GLA_DK), ak.reshape(B_, S_, GLA_HEADS, GLA_DK),
                     av.reshape(B_, S_, GLA_HEADS, GLA_DV), log_a.reshape(B_, S_, GLA_HEADS, GLA_DK))
    oa = rmsnorm(oa, gla_gain).reshape(B_, S_, A_WIDTH) * jax.nn.silu(a_gate)
    ob = swa_attention(bq.reshape(B_, S_, SWA_HEADS, SWA_DH), bk.reshape(B_, S_, SWA_KV_HEADS, SWA_DH),
                       bv.reshape(B_, S_, SWA_KV_HEADS, SWA_DH), sinks, rel_bias) * jax.nn.silu(b_gate)
    return jnp.concatenate([oa, ob], axis=-1) @ w_out


def odd_layer(hn, w_in, w_out, rel_bias):
    B_, S_, _ = hn.shape
    cq, ck, cv, c_gate = split_cols(hn @ w_in, ODD_SPLITS)
    oc = moba_attention(cq.reshape(B_, S_, MOBA_HEADS, MOBA_DH), ck.reshape(B_, S_, MOBA_KV_HEADS, MOBA_DH),
                        cv.reshape(B_, S_, MOBA_KV_HEADS, MOBA_DH), rel_bias)
    return (oc * jax.nn.silu(c_gate)) @ w_out


def setup_inputs(seed: int = 0) -> dict:
    key = jax.random.key(seed)
    ks = jax.random.split(key, 12)
    f32 = jnp.float32
    x = jax.random.normal(ks[0], (BATCH, SEQ, D_MODEL), f32)
    norm_gain = 1.0 + 0.02 * jax.random.normal(ks[1], (DEPTH, D_MODEL), f32)
    final_gain = 1.0 + 0.02 * jax.random.normal(ks[2], (D_MODEL,), f32)
    rel_bias = 0.2 * jax.random.normal(ks[3], (REL_BUCKETS, ATTN_HEADS), f32)
    w_in_even = jax.random.normal(ks[4], (N_EVEN, D_MODEL, EVEN_COLS), f32) * D_MODEL ** -0.5
    gla_w_up = jax.random.normal(ks[5], (N_EVEN, GLA_RANK, GLA_HEADS * GLA_DK), f32) * GLA_RANK ** -0.5
    gla_b_up = 0.1 * jax.random.normal(ks[6], (N_EVEN, GLA_HEADS * GLA_DK), f32)
    gla_norm_gain = 1.0 + 0.02 * jax.random.normal(ks[7], (N_EVEN, GLA_DV), f32)
    swa_sinks = 0.5 * jax.random.normal(ks[8], (N_EVEN, SWA_HEADS), f32)
    w_out_even = jax.random.normal(ks[9], (N_EVEN, EVEN_WIDTH, D_MODEL), f32) * EVEN_WIDTH ** -0.5
    w_in_odd = jax.random.normal(ks[10], (N_ODD, D_MODEL, ODD_COLS), f32) * D_MODEL ** -0.5
    w_out_odd = jax.random.normal(ks[11], (N_ODD, C_WIDTH, D_MODEL), f32) * C_WIDTH ** -0.5
    return {"x": x, "norm_gain": norm_gain, "final_gain": final_gain, "rel_bias": rel_bias,
            "w_in_even": w_in_even, "gla_w_up": gla_w_up, "gla_b_up": gla_b_up,
            "gla_norm_gain": gla_norm_gain, "swa_sinks": swa_sinks, "w_out_even": w_out_even,
            "w_in_odd": w_in_odd, "w_out_odd": w_out_odd}


def reference(x, norm_gain, final_gain, rel_bias, w_in_even, gla_w_up, gla_b_up, gla_norm_gain,
              swa_sinks, w_out_even, w_in_odd, w_out_odd):
    h = x
    for layer in range(DEPTH):
        hn = rmsnorm(h, norm_gain[layer])
        if layer % 2 == 0:
            i = layer // 2
            h = h + even_layer(hn, w_in_even[i], gla_w_up[i], gla_b_up[i], gla_norm_gain[i],
                               swa_sinks[i], w_out_even[i], rel_bias)
        else:
            i = layer // 2
            h = h + odd_layer(hn, w_in_odd[i], w_out_odd[i], rel_bias)
    return rmsnorm(h, final_gain)
```

```cpp
#include <hip/hip_runtime.h>
#include <math.h>

constexpr int D = 1024, NB = 2, S = 8192, M = NB * S;
constexpr int EC = 2832, OC = 2560;
constexpr int C_AQ = 0, C_AK = 256, C_AV = 512, C_AD = 1024, C_AG = 1040, C_BQ = 1552, C_BK = 2064, C_BV = 2192, C_BG = 2320;
constexpr int C_CQ = 0, C_CK = 1024, C_CV = 1280, C_CG = 1536;

__device__ __forceinline__ float wave_sum(float v) {
#pragma unroll
    for (int o = 1; o < 64; o <<= 1) v += __shfl_xor(v, o);
    return v;
}
__device__ __forceinline__ float wave_max(float v) {
#pragma unroll
    for (int o = 1; o < 64; o <<= 1) v = fmaxf(v, __shfl_xor(v, o));
    return v;
}
__device__ __forceinline__ float silu(float x) { return x / (1.f + expf(-x)); }
__device__ __forceinline__ int t5_bucket(int dist) {
    int n = dist > 0 ? dist : 0;
    if (n < 16) return n;
    float nf = (float)n;
    int large = 16 + (int)(logf(nf / 16.f) / 2.0794415416798357f * 16.f);
    return large < 31 ? large : 31;
}

__global__ void __launch_bounds__(256) k_rmsnorm(const float* x, const float* g, float* y) {
    const int row = blockIdx.x * 4 + (threadIdx.x >> 6), lane = threadIdx.x & 63;
    const float4* xr = (const float4*)(x + (size_t)row * D);
    const float4* gr = (const float4*)g;
    float4 v[4]; float s = 0.f;
#pragma unroll
    for (int j = 0; j < 4; ++j) { v[j] = xr[lane + 64 * j]; s += v[j].x * v[j].x + v[j].y * v[j].y + v[j].z * v[j].z + v[j].w * v[j].w; }
    s = wave_sum(s);
    const float rs = 1.0f / sqrtf(s * (1.0f / D) + 1e-6f);
    float4* yr = (float4*)(y + (size_t)row * D);
#pragma unroll
    for (int j = 0; j < 4; ++j) { float4 gg = gr[lane + 64 * j]; float4 o; o.x = v[j].x * rs * gg.x; o.y = v[j].y * rs * gg.y; o.z = v[j].z * rs * gg.z; o.w = v[j].w * rs * gg.w; yr[lane + 64 * j] = o; }
}

template <bool RES>
__global__ void __launch_bounds__(256) k_gemm(const float* A, const float* W, float* C, const float* R, int N, int K) {
    __shared__ float As[16][68];
    __shared__ float Ws[16][68];
    const int tid = threadIdx.x, tx = tid & 15, ty = tid >> 4;
    const int m0 = blockIdx.y * 64, n0 = blockIdx.x * 64;
    float acc[4][4];
#pragma unroll
    for (int i = 0; i < 4; ++i)
#pragma unroll
        for (int j = 0; j < 4; ++j) acc[i][j] = 0.f;
    for (int k0 = 0; k0 < K; k0 += 16) {
#pragma unroll
        for (int i = 0; i < 4; ++i) { const int idx = tid + 256 * i, r = idx >> 4, kk = idx & 15; As[kk][r] = A[(size_t)(m0 + r) * K + k0 + kk]; }
#pragma unroll
        for (int i = 0; i < 4; ++i) { const int idx = tid + 256 * i, kk = idx >> 6, c = idx & 63; Ws[kk][c] = (n0 + c < N) ? W[(size_t)(k0 + kk) * N + n0 + c] : 0.f; }
        __syncthreads();
#pragma unroll
        for (int kk = 0; kk < 16; ++kk) {
            float a[4], b[4];
#pragma unroll
            for (int i = 0; i < 4; ++i) { a[i] = As[kk][ty * 4 + i]; b[i] = Ws[kk][tx * 4 + i]; }
#pragma unroll
            for (int i = 0; i < 4; ++i)
#pragma unroll
                for (int j = 0; j < 4; ++j) acc[i][j] += a[i] * b[j];
        }
        __syncthreads();
    }
#pragma unroll
    for (int i = 0; i < 4; ++i)
#pragma unroll
        for (int j = 0; j < 4; ++j) {
            const int r = m0 + ty * 4 + i, c = n0 + tx * 4 + j;
            if (c < N) { float v = acc[i][j]; if (RES) v += R[(size_t)r * N + c]; C[(size_t)r * N + c] = v; }
        }
}

__global__ void __launch_bounds__(256) k_gla(const float* proj, const float* w_up, const float* b_up, float* mix) {
    const int tid = threadIdx.x, d = tid & 63, eg = tid >> 6;
    const int bh = blockIdx.x >> 3, sl = blockIdx.x & 7, b = bh >> 2, h = bh & 3;
    const int e0 = sl * 16 + eg * 4;
    float wu[16];
#pragma unroll
    for (int r = 0; r < 16; ++r) wu[r] = w_up[r * 256 + h * 64 + d];
    const float bu = b_up[h * 64 + d];
    float st[4] = {0.f, 0.f, 0.f, 0.f};
#pragma unroll 4
    for (int t = 0; t < S; ++t) {
        const float* pr = proj + (size_t)(b * S + t) * EC;
        const float q = pr[C_AQ + h * 64 + d] * 0.125f, k = pr[C_AK + h * 64 + d];
        float z = bu;
#pragma unroll
        for (int r = 0; r < 16; ++r) z += pr[C_AD + r] * wu[r];
        const float ls = fminf(z, 0.f) - log1pf(expf(-fabsf(z)));
        const float alpha = expf(ls * (1.0f / 16.0f));
        const float4 v = *(const float4*)(pr + C_AV + h * 128 + e0);
        st[0] = alpha * st[0] + k * v.x; st[1] = alpha * st[1] + k * v.y; st[2] = alpha * st[2] + k * v.z; st[3] = alpha * st[3] + k * v.w;
        float o0 = wave_sum(q * st[0]), o1 = wave_sum(q * st[1]), o2 = wave_sum(q * st[2]), o3 = wave_sum(q * st[3]);
        if (d == 0) { float4 o; o.x = o0; o.y = o1; o.z = o2; o.w = o3; *(float4*)(mix + (size_t)(b * S + t) * D + h * 128 + e0) = o; }
    }
}
__global__ void __launch_bounds__(256) k_gla_post(const float* proj, const float* gain, float* mix) {
    const int item = blockIdx.x * 4 + (threadIdx.x >> 6), lane = threadIdx.x & 63;
    const int row = item >> 2, h = item & 3;
    float* o = mix + (size_t)row * D + h * 128;
    const float a = o[lane], c = o[lane + 64];
    const float s = wave_sum(a * a + c * c);
    const float rs = 1.0f / sqrtf(s * (1.0f / 128.f) + 1e-6f);
    const float* g = proj + (size_t)row * EC + C_AG + h * 128;
    o[lane] = a * rs * gain[lane] * silu(g[lane]);
    o[lane + 64] = c * rs * gain[lane + 64] * silu(g[lane + 64]);
}

__global__ void __launch_bounds__(64) k_swa(const float* proj, const float* sinks, const float* rel_bias, float* mix) {
    const int gid = blockIdx.x * 64 + threadIdx.x;
    const int h = gid & 7, row = gid >> 3, b = row / S, t = row % S, kvh = h >> 2;
    const float* pr = proj + (size_t)row * EC;
    float q[64];
#pragma unroll
    for (int i = 0; i < 64; ++i) q[i] = pr[C_BQ + h * 64 + i] * 0.125f;
    float m = sinks[h], l = 1.f, o[64];
#pragma unroll
    for (int i = 0; i < 64; ++i) o[i] = 0.f;
    const int j0 = t - 127 > 0 ? t - 127 : 0;
    for (int j = j0; j <= t; ++j) {
        const float* kr = proj + (size_t)(b * S + j) * EC + C_BK + kvh * 64;
        const float* vr = proj + (size_t)(b * S + j) * EC + C_BV + kvh * 64;
        float s = 0.f;
#pragma unroll
        for (int i = 0; i < 64; ++i) s += q[i] * kr[i];
        s += rel_bias[t5_bucket(t - j) * 8 + h];
        const float mn = fmaxf(m, s), f = expf(m - mn), p = expf(s - mn);
        l = l * f + p; m = mn;
#pragma unroll
        for (int i = 0; i < 64; ++i) o[i] = o[i] * f + p * vr[i];
    }
    const float inv = 1.f / l;
#pragma unroll
    for (int i = 0; i < 64; ++i) mix[(size_t)row * D + 512 + h * 64 + i] = o[i] * inv * silu(pr[C_BG + h * 64 + i]);
}

__global__ void __launch_bounds__(128) k_kmean(const float* proj, float* kmean) {
    const int item = blockIdx.x, d = threadIdx.x;
    const int n = item & 31, bk = item >> 5, b = bk >> 1, kvh = bk & 1;
    float s = 0.f;
    for (int r = 0; r < 256; ++r) s += proj[(size_t)(b * S + n * 256 + r) * OC + C_CK + kvh * 128 + d];
    kmean[(size_t)item * 128 + d] = s * (1.0f / 256.f);
}

__global__ void __launch_bounds__(256) k_moba(const float* proj, const float* kmean, const float* rel_bias, float* mix) {
    __shared__ float qs[4][128];
    const int w = threadIdx.x >> 6, lane = threadIdx.x & 63;
    const int item = blockIdx.x * 4 + w;
    const int h = item & 7, row = item >> 3, b = row / S, t = row % S, kvh = h >> 2, own = t >> 8;
    const float* pr = proj + (size_t)row * OC;
    qs[w][lane] = pr[C_CQ + h * 128 + lane]; qs[w][lane + 64] = pr[C_CQ + h * 128 + lane + 64];
    __syncthreads();
    const float4* q4 = (const float4*)qs[w];
    float gate = -INFINITY;
    if (lane < own) { const float4* km = (const float4*)(kmean + ((size_t)((b * 2 + kvh) * 32 + lane)) * 128); float s = 0.f;
        for (int i = 0; i < 32; ++i) { const float4 a = q4[i], c = km[i]; s += a.x * c.x + a.y * c.y + a.z * c.z + a.w * c.w; } gate = s; }
    int s0 = -1, s1 = -1, s2 = -1;
#pragma unroll
    for (int r = 0; r < 3; ++r) {
        const float mx = wave_max(gate);
        int idx = -1;
        if (mx != -INFINITY) { const unsigned long long bal = __ballot(gate == mx); idx = __ffsll((long long)bal) - 1; if (lane == idx) gate = -INFINITY; }
        if (r == 0) s0 = idx; else if (r == 1) s1 = idx; else s2 = idx;
    }
    const float scale = 0.08838834764831845f;
    float m = -INFINITY, l = 0.f, o0 = 0.f, o1 = 0.f;
    for (int si = 0; si < 4; ++si) {
        const int blk = si == 0 ? s0 : (si == 1 ? s1 : (si == 2 ? s2 : own));
        if (blk < 0) continue;
        for (int c = 0; c < 4; ++c) {
            const int kpos = blk * 256 + c * 64 + lane;
            float s = -INFINITY;
            if (kpos <= t) {
                const float4* kr = (const float4*)(proj + (size_t)(b * S + kpos) * OC + C_CK + kvh * 128);
                float a = 0.f;
                for (int i = 0; i < 32; ++i) { const float4 qq = q4[i], kk = kr[i]; a += qq.x * kk.x + qq.y * kk.y + qq.z * kk.z + qq.w * kk.w; }
                s = a * scale + rel_bias[t5_bucket(t - kpos) * 8 + h];
            }
            const float cm = wave_max(s);
            if (cm == -INFINITY) continue;
            const float mn = fmaxf(m, cm), f = expf(m - mn), p = expf(s - mn);
            l = l * f + wave_sum(p); m = mn; o0 *= f; o1 *= f;
            for (int j = 0; j < 64; ++j) {
                const float pj = __shfl(p, j);
                const float* vr = proj + (size_t)(b * S + blk * 256 + c * 64 + j) * OC + C_CV + kvh * 128;
                o0 += pj * vr[lane]; o1 += pj * vr[lane + 64];
            }
        }
    }
    const float inv = 1.f / l;
    mix[(size_t)row * D + h * 128 + lane] = o0 * inv * silu(pr[C_CG + h * 128 + lane]);
    mix[(size_t)row * D + h * 128 + lane + 64] = o1 * inv * silu(pr[C_CG + h * 128 + lane + 64]);
}

extern "C" void kernel_launch(void* const* d_in, const int* in_sizes, int n_in, void* d_out, int out_size, void* d_ws, size_t ws_size, hipStream_t stream) {
    const float* x = (const float*)d_in[0];
    const float* norm_gain = (const float*)d_in[1];
    const float* final_gain = (const float*)d_in[2];
    const float* rel_bias = (const float*)d_in[3];
    const float* w_in_even = (const float*)d_in[4];
    const float* gla_w_up = (const float*)d_in[5];
    const float* gla_b_up = (const float*)d_in[6];
    const float* gla_gain = (const float*)d_in[7];
    const float* sinks = (const float*)d_in[8];
    const float* w_out_even = (const float*)d_in[9];
    const float* w_in_odd = (const float*)d_in[10];
    const float* w_out_odd = (const float*)d_in[11];
    float* out = (float*)d_out;
    float* xn = (float*)d_ws;
    float* proj = xn + (size_t)M * D;
    float* kmean = proj + (size_t)M * EC;
    k_rmsnorm<<<M / 4, 256, 0, stream>>>(x, norm_gain, xn);
    k_gemm<false><<<dim3((EC + 63) / 64, M / 64), 256, 0, stream>>>(xn, w_in_even, proj, nullptr, EC, D);
    k_gla<<<64, 256, 0, stream>>>(proj, gla_w_up, gla_b_up, xn);
    k_gla_post<<<M, 256, 0, stream>>>(proj, gla_gain, xn);
    k_swa<<<M * 8 / 64, 64, 0, stream>>>(proj, sinks, rel_bias, xn);
    k_gemm<true><<<dim3(D / 64, M / 64), 256, 0, stream>>>(xn, w_out_even, out, x, D, D);
    k_rmsnorm<<<M / 4, 256, 0, stream>>>(out, norm_gain + D, xn);
    k_gemm<false><<<dim3(OC / 64, M / 64), 256, 0, stream>>>(xn, w_in_odd, proj, nullptr, OC, D);
    k_kmean<<<128, 128, 0, stream>>>(proj, kmean);
    k_moba<<<M * 8 / 4, 256, 0, stream>>>(proj, kmean, rel_bias, xn);
    k_gemm<true><<<dim3(D / 64, M / 64), 256, 0, stream>>>(xn, w_out_odd, out, out, D, D);
    k_rmsnorm<<<M / 4, 256, 0, stream>>>(out, final_gain, out);
}
```

```cpp
#include <hip/hip_runtime.h>
#include <cstdio>
#include <cstdint>
#include <math.h>
namespace pg8 {
#define PG8_LAS __attribute__((address_space(3)))
typedef unsigned short bf16_t;
typedef short bf16x8 __attribute__((ext_vector_type(8)));
typedef float f32x4 __attribute__((ext_vector_type(4)));
typedef unsigned u32x4 __attribute__((ext_vector_type(4)));
constexpr int BM = 256, BK = 64, HALF = 128, HTB = HALF * BK * 2  , STAGE_BYTES = 8 * HTB, NXCD = 8, WGM = 8;

__host__ __device__ __forceinline__ int lds_byte(int r, int c) { const int st = (r >> 4) * 2 + (c >> 5), rr = r & 15, cc = c & 31, ob = rr * 64 + cc * 2; return st * 1024 + (ob ^ (((ob >> 9) & 1) << 5)); }
__host__ __device__ __forceinline__ void stage_rc(int b, int& R, int& C) { const int st = b / 1024, sb = b % 1024, swz = sb ^ (((sb >> 9) & 1) << 5); R = (st >> 1) * 16 + swz / 64; C = (st & 1) * 32 + (swz % 64) / 2; }
__host__ __device__ __forceinline__ int perm32(int rho) { const int n = rho >> 4, i = rho & 15; return 8 * (i >> 2) + 4 * n + (i & 3); }

struct Unit { int pm, pn; };
struct Gemm { const bf16_t* A; const bf16_t* Bt; int M, N, K; };

struct StaticOrder {
    int nM, nN, nwg, G, c;
    __host__ __device__ void init(int M, int N, int G_, int c_) { nM = M / BM; nN = N / BM; nwg = nM * nN; G = G_; c = c_; }
    __host__ __device__ bool next(int i, Unit& u) const {
        const long L = (long)i * G + c; if (L >= nwg) return false;
        int wgid = (int)L; { const int q = nwg / NXCD, r = nwg % NXCD, xcd = wgid % NXCD, off = wgid / NXCD; wgid = (xcd < r ? xcd * (q + 1) : r * (q + 1) + (xcd - r) * q) + off; }
        const int nig = WGM * nN, gid = wgid / nig, fm = gid * WGM, gsz = (nM - fm) < WGM ? (nM - fm) : WGM;
        u.pm = fm + ((wgid % nig) % gsz); u.pn = (wgid % nig) / gsz; return true;
    }
    __device__ __forceinline__ void a_ready(const Unit&) const {}
    __device__ __forceinline__ void done(const Unit&) const {}
};

__device__ __forceinline__ unsigned cvt_pk_bf16(float lo, float hi) { unsigned r; asm volatile("v_cvt_pk_bf16_f32 %0, %1, %2" : "=v"(r) : "v"(lo), "v"(hi)); return r; }
typedef float f32x2 __attribute__((ext_vector_type(2)));
typedef unsigned u32x4 __attribute__((ext_vector_type(4)));
struct EpiProj {
    static constexpr bool PERM = true, AFTER_DRAIN = false;
    bf16_t* O; int ldc; unsigned maskA; float sA; unsigned maskB; float sB;
    __device__ __forceinline__ void operator()(const f32x4 (&acc)[2][2][4][2], const Unit& u, int wr, int wc, int fr, int fq) const {
        const float sc = ((maskA >> u.pn) & 1u) ? sA : (((maskB >> u.pn) & 1u) ? sB : 1.f);
        const int row0 = u.pm * BM + wr * 64 + fr, col0 = u.pn * BM + wc * 32 + 8 * fq;
#pragma unroll
        for (int ai = 0; ai < 2; ++ai)
#pragma unroll
            for (int m = 0; m < 4; ++m) { bf16_t* rowp = O + (size_t)(row0 + ai * HALF + m * 16) * ldc + col0;
#pragma unroll
                for (int bj = 0; bj < 2; ++bj) { const f32x4 v0 = acc[ai][bj][m][0] * sc, v1 = acc[ai][bj][m][1] * sc;
                    u32x4 w; w.x = cvt_pk_bf16(v0[0], v0[1]); w.y = cvt_pk_bf16(v0[2], v0[3]); w.z = cvt_pk_bf16(v1[0], v1[1]); w.w = cvt_pk_bf16(v1[2], v1[3]);
                    *(u32x4*)(rowp + bj * HALF) = w; } }
    }
};
struct EpiRes {
    static constexpr bool PERM = false, AFTER_DRAIN = false;
    const float* base; float* out; int ldc;
    __device__ __forceinline__ void operator()(const f32x4 (&acc)[2][2][4][2], const Unit& u, int wr, int wc, int fr, int fq) const {
        const int col0 = u.pn * BM + wc * 32 + 4 * fq;
#pragma unroll
        for (int ai = 0; ai < 2; ++ai)
#pragma unroll
            for (int m = 0; m < 4; ++m) { const size_t off = (size_t)(u.pm * BM + ai * HALF + wr * 64 + m * 16 + fr) * ldc + col0;
#pragma unroll
                for (int bj = 0; bj < 2; ++bj)
#pragma unroll
                    for (int n = 0; n < 2; ++n) { const f32x4 bs = *(const f32x4*)(base + off + bj * HALF + n * 16); *(f32x4*)(out + off + bj * HALF + n * 16) = bs + acc[ai][bj][m][n]; } }
    }
};
template <class Epi, class Sched, bool ALIGN_EPI = false, bool SP2 = false>
__device__ __forceinline__ void gemm_phase(PG8_LAS unsigned char* lds, const Gemm g, const Sched& S, const Epi& E) {
    const int tid = threadIdx.x, wid = __builtin_amdgcn_readfirstlane(tid >> 6), lane = tid & 63, wr = wid >> 2, wc = wid & 3, fr = lane & 15, fq = lane >> 4;
    const int K = g.K, nt = K / BK;
    unsigned voffA[2], voffB[2];
#pragma unroll
    for (int i = 0; i < 2; ++i) { int R, C; stage_rc(tid * 16 + i * 8192, R, C); const int Rb = Epi::PERM ? ((R & ~31) + perm32(R & 31)) : R;
        voffA[i] = (unsigned)(R * K + C) * 2u; voffB[i] = (unsigned)(Rb * K + C) * 2u; }
    const size_t kstep = (size_t)(BK * 2);
    const size_t hstep = (size_t)HALF * K * 2;
    const size_t tstep = 2 * hstep;
    const unsigned ldsw = (unsigned)wid * 1024u;
    const int aoff = lds_byte(wr * 64 + fr, fq * 8), boff = lds_byte(wc * 32 + fr, fq * 8);
#define PG8_SA(b, h) (((b) * 2 + (h)) * HTB)
#define PG8_SB(b, h) ((4 + (b) * 2 + (h)) * HTB)
#define PG8_STAGE(bufoff, gbase, voff) do { _Pragma("unroll") for (int _i = 0; _i < 2; ++_i) \
        __builtin_amdgcn_global_load_lds((const unsigned*)((const char*)(gbase) + (voff)[_i]), (PG8_LAS unsigned*)(lds + (bufoff) + ldsw + _i * 8192), 16, 0, 0); } while (0)
#define PG8_LDA(dst, b, h) do { _Pragma("unroll") for (int m = 0; m < 4; ++m) _Pragma("unroll") for (int k = 0; k < 2; ++k) dst[m][k] = *(const PG8_LAS bf16x8*)(lds + PG8_SA(b, h) + aoff + m * 2048 + k * 1024); } while (0)
#define PG8_LDB(dst, b, h) do { _Pragma("unroll") for (int n = 0; n < 2; ++n) _Pragma("unroll") for (int k = 0; k < 2; ++k) dst[n][k] = *(const PG8_LAS bf16x8*)(lds + PG8_SB(b, h) + boff + n * 2048 + k * 1024); } while (0)
#define PG8_MMA(ai, bj, At, Bt) do { __builtin_amdgcn_s_setprio(1); _Pragma("unroll") for (int m = 0; m < 4; ++m) _Pragma("unroll") for (int n = 0; n < 2; ++n) _Pragma("unroll") for (int k = 0; k < 2; ++k) \
        acc[ai][bj][m][n] = __builtin_amdgcn_mfma_f32_16x16x32_bf16(Bt[n][k], At[m][k], acc[ai][bj][m][n], 0, 0, 0); __builtin_amdgcn_s_setprio(0); } while (0)
#define PG8_WAIT_V(n) asm volatile("s_waitcnt vmcnt(" #n ")" ::: "memory")
#define PG8_WAIT_L(n) asm volatile("s_waitcnt lgkmcnt(" #n ")" ::: "memory")
#define PG8_BAR __builtin_amdgcn_s_barrier()
#define PG8_SCHED __builtin_amdgcn_sched_barrier(0)
    Unit cur, nxt; int ui = 0;
    if (!S.next(0, cur)) return;
    f32x4 acc[2][2][4][2];
#pragma unroll
    for (int a = 0; a < 2; ++a)
#pragma unroll
        for (int b = 0; b < 2; ++b)
#pragma unroll
            for (int m = 0; m < 4; ++m)
#pragma unroll
                for (int n = 0; n < 2; ++n) acc[a][b][m][n] = (f32x4){0.f, 0.f, 0.f, 0.f};
    bf16x8 At[4][2], B0[2][2], B1[2][2];
    const char* cA = (const char*)g.A + (size_t)cur.pm * tstep; const char* cB = (const char*)g.Bt + (size_t)cur.pn * tstep;
    S.a_ready(cur);
    if constexpr (SP2) {
        PG8_STAGE(PG8_SB(0, 0), cB, voffB); PG8_STAGE(PG8_SB(0, 1), cB + hstep, voffB); PG8_STAGE(PG8_SA(0, 0), cA, voffA); PG8_STAGE(PG8_SA(0, 1), cA + hstep, voffA);
        if (wr == 1) PG8_BAR;
        PG8_WAIT_V(2); PG8_BAR;
        PG8_STAGE(PG8_SB(1, 0), cB + kstep, voffB); PG8_STAGE(PG8_SA(1, 0), cA + kstep, voffA); PG8_STAGE(PG8_SB(1, 1), cB + hstep + kstep, voffB);
        PG8_WAIT_V(6); PG8_BAR;
    } else {
        PG8_STAGE(PG8_SB(0, 0), cB, voffB); PG8_STAGE(PG8_SA(0, 0), cA, voffA); PG8_STAGE(PG8_SB(0, 1), cB + hstep, voffB); PG8_STAGE(PG8_SA(0, 1), cA + hstep, voffA);
        if (wr == 1) PG8_BAR;
        PG8_WAIT_V(4); PG8_BAR;
        PG8_STAGE(PG8_SB(1, 0), cB + kstep, voffB); PG8_STAGE(PG8_SA(1, 0), cA + kstep, voffA); PG8_STAGE(PG8_SB(1, 1), cB + hstep + kstep, voffB);
        PG8_WAIT_V(6); PG8_BAR;
    }
    for (;;) {
        const bool has_next = S.next(ui + 1, nxt);
        const char* nA = has_next ? (const char*)g.A + (size_t)nxt.pm * tstep : cA; const char* nB = has_next ? (const char*)g.Bt + (size_t)nxt.pn * tstep : cB;
        for (int t = 0; t < nt; t += 2) {
            const bool last = (t == nt - 2);
            const char* a1 = cA + (size_t)(t + 1) * kstep;
            const char* a2 = last ? nA : cA + (size_t)(t + 2) * kstep; const char* b2 = last ? nB : cB + (size_t)(t + 2) * kstep;
            const char* a3 = a2 + kstep; const char* b3 = b2 + kstep;
            if (last && has_next) S.a_ready(nxt);
            if constexpr (SP2) {
            PG8_LDB(B0, 0, 0); PG8_LDB(B1, 0, 1); PG8_SCHED; PG8_LDA(At, 0, 0); PG8_STAGE(PG8_SA(1, 1), a1 + hstep, voffA);
            PG8_WAIT_V(8); PG8_WAIT_L(0); PG8_BAR; PG8_MMA(0, 0, At, B0); PG8_MMA(0, 1, At, B1); PG8_BAR; PG8_SCHED;
            PG8_LDA(At, 0, 1); PG8_STAGE(PG8_SB(0, 0), b2, voffB); PG8_STAGE(PG8_SB(0, 1), b2 + hstep, voffB); PG8_STAGE(PG8_SA(0, 0), a2, voffA);
            PG8_WAIT_V(8); PG8_WAIT_L(0); PG8_BAR; PG8_MMA(1, 0, At, B0); PG8_MMA(1, 1, At, B1); PG8_BAR; PG8_SCHED;
            PG8_LDB(B0, 1, 0); PG8_LDB(B1, 1, 1); PG8_SCHED; PG8_LDA(At, 1, 0); PG8_STAGE(PG8_SA(0, 1), a2 + hstep, voffA);
            PG8_WAIT_V(8); PG8_WAIT_L(0); PG8_BAR; PG8_MMA(0, 0, At, B0); PG8_MMA(0, 1, At, B1); PG8_BAR; PG8_SCHED;
            PG8_LDA(At, 1, 1); PG8_STAGE(PG8_SB(1, 0), b3, voffB); PG8_STAGE(PG8_SB(1, 1), b3 + hstep, voffB); PG8_STAGE(PG8_SA(1, 0), a3, voffA);
            PG8_WAIT_V(8); PG8_WAIT_L(0); PG8_BAR; PG8_MMA(1, 0, At, B0); PG8_MMA(1, 1, At, B1); PG8_BAR; PG8_SCHED;
            } else {
            PG8_LDB(B0, 0, 0); PG8_SCHED; PG8_LDA(At, 0, 0); PG8_STAGE(PG8_SA(1, 1), a1 + hstep, voffA);
            PG8_WAIT_L(8); PG8_BAR; PG8_WAIT_L(0); PG8_MMA(0, 0, At, B0); PG8_BAR; PG8_SCHED;
            PG8_LDB(B1, 0, 1); PG8_STAGE(PG8_SB(0, 0), b2, voffB);
            PG8_BAR; PG8_WAIT_L(0); PG8_MMA(0, 1, At, B1); PG8_BAR;
            PG8_LDA(At, 0, 1); PG8_STAGE(PG8_SA(0, 0), a2, voffA);
            PG8_BAR; PG8_WAIT_L(0); PG8_MMA(1, 0, At, B0); PG8_BAR; PG8_SCHED;
            PG8_STAGE(PG8_SB(0, 1), b2 + hstep, voffB);
            PG8_WAIT_V(6); PG8_BAR; PG8_MMA(1, 1, At, B1); PG8_BAR;
            PG8_LDB(B0, 1, 0); PG8_SCHED; PG8_LDA(At, 1, 0); PG8_STAGE(PG8_SA(0, 1), a2 + hstep, voffA);
            PG8_WAIT_L(8); PG8_BAR; PG8_WAIT_L(0); PG8_MMA(0, 0, At, B0); PG8_BAR; PG8_SCHED;
            PG8_LDB(B1, 1, 1); PG8_STAGE(PG8_SB(1, 0), b3, voffB);
            PG8_BAR; PG8_WAIT_L(0); PG8_MMA(0, 1, At, B1); PG8_BAR;
            PG8_LDA(At, 1, 1); PG8_STAGE(PG8_SA(1, 0), a3, voffA);
            PG8_BAR; PG8_WAIT_L(0); PG8_MMA(1, 0, At, B0); PG8_BAR; PG8_SCHED;
            PG8_STAGE(PG8_SB(1, 1), b3 + hstep, voffB);
            PG8_WAIT_V(6); PG8_BAR; PG8_MMA(1, 1, At, B1); PG8_BAR;
            }
        }
        if constexpr (ALIGN_EPI) { if (wr == 0) PG8_BAR; }
        if constexpr (!Epi::AFTER_DRAIN) { E(acc, cur, wr, wc, fr, fq); S.done(cur); }
        if (!has_next) break;
#pragma unroll
        for (int a = 0; a < 2; ++a)
#pragma unroll
            for (int b = 0; b < 2; ++b)
#pragma unroll
                for (int m = 0; m < 4; ++m)
#pragma unroll
                    for (int n = 0; n < 2; ++n) acc[a][b][m][n] = (f32x4){0.f, 0.f, 0.f, 0.f};
        cur = nxt; cA = nA; cB = nB; ++ui;
        if constexpr (ALIGN_EPI) { if (wr == 1) PG8_BAR; }
    }
    PG8_WAIT_V(0);
    if constexpr (!ALIGN_EPI) { if (wr == 0) PG8_BAR; }
    PG8_BAR;
    if constexpr (Epi::AFTER_DRAIN) { E.fused(acc, cur, wr, wc, fr, fq, lds, wid, lane); S.done(cur); }
#undef PG8_SA
#undef PG8_SB
#undef PG8_STAGE
#undef PG8_LDA
#undef PG8_LDB
#undef PG8_MMA
#undef PG8_WAIT_V
#undef PG8_WAIT_L
#undef PG8_BAR
#undef PG8_SCHED
}
}

constexpr int NWAVES = 8, NTHR = 512;
constexpr int NB = 2, SEQ = 8192, DM = 1024, M = NB * SEQ;
constexpr int EC_SRC = 2832, OC_SRC = 2560, N0 = 2816, N1 = 2560;
constexpr int P0_AQ = 0, P0_AK = 256, P0_AV = 512, P0_AG = 1024, P0_BQ = 1536, P0_BK = 2048, P0_BV = 2176, P0_BG = 2304;
constexpr int P1_CQ = 0, P1_CK = 1024, P1_CV = 1280, P1_CG = 1536;
constexpr float LOG2E = 1.4426950408889634f;
constexpr float EPS = 1e-6f;
constexpr int NPHASE = 12;

constexpr size_t MiB = 1u << 20;
constexpr size_t WS_CTL = 0, CTL_ZERO_BYTES = 64 * 1024;
constexpr size_t WS_KMEAN = 1 * MiB;
constexpr size_t WS_DEC = 1 * MiB + 128 * 1024;
constexpr size_t WS_WT0 = 2 * MiB, WS_WTO0 = 8 * MiB, WS_WT1 = 10 * MiB, WS_WTO1 = 15 * MiB;
constexpr size_t WS_LOGA = 17 * MiB;
constexpr size_t WS_XN = 33 * MiB;
constexpr size_t WS_MIX = 65 * MiB;
constexpr size_t WS_PROJ = 97 * MiB;
constexpr size_t WS_ST = 185 * MiB;
constexpr size_t WS_END = 201 * MiB;
constexpr size_t DO_KVC = 0;
constexpr size_t DO_GO = 32 * MiB;
constexpr int CW_BAR = 1024;

constexpr int RING_BYTES = 131072;
constexpr int LDSCTL_OFF = RING_BYTES, MISC_OFF = LDSCTL_OFF + 320;
constexpr int LDS_BYTES = 147456;

#define GAS __attribute__((address_space(1)))
#define LAS __attribute__((address_space(3)))
typedef unsigned short bf16;
typedef unsigned v4u __attribute__((ext_vector_type(4)));
typedef unsigned v2u __attribute__((ext_vector_type(2)));
typedef float f32x4 __attribute__((ext_vector_type(4)));
typedef float f32x16 __attribute__((ext_vector_type(16)));
typedef short bf16x8 __attribute__((ext_vector_type(8)));
typedef GAS unsigned gu32;
#define RLX_AGENT __ATOMIC_RELAXED, __HIP_MEMORY_SCOPE_AGENT
#define LDS_WAIT() asm volatile("s_waitcnt lgkmcnt(0)" ::: "memory")
#define VM_WAIT() asm volatile("s_waitcnt vmcnt(0)" ::: "memory")
__device__ __forceinline__ unsigned f2bf(float f) { unsigned u = __builtin_bit_cast(unsigned, f); return (u + 0x7fffu + ((u >> 16) & 1u)) >> 16; }
__device__ __forceinline__ unsigned pk2(float lo, float hi) { return f2bf(lo) | (f2bf(hi) << 16); }
__device__ __forceinline__ float bf2f(bf16 v) { return __builtin_bit_cast(float, (unsigned)v << 16); }
__device__ __forceinline__ float bflo(unsigned w) { return __builtin_bit_cast(float, w << 16); }
__device__ __forceinline__ float bfhi(unsigned w) { return __builtin_bit_cast(float, w & 0xffff0000u); }
__device__ __forceinline__ float wave_sum(float v) {
#pragma unroll
    for (int o = 1; o < 64; o <<= 1) v += __shfl_xor(v, o);
    return v;
}
__device__ __forceinline__ float wave_max(float v) {
#pragma unroll
    for (int o = 1; o < 64; o <<= 1) v = fmaxf(v, __shfl_xor(v, o));
    return v;
}
__device__ __forceinline__ float silu_f(float x) { return x / (1.f + __expf(-x)); }
__device__ __forceinline__ int t5_bucket(int dist) {
    const int n = dist > 0 ? dist : 0;
    if (n < 16) return n;
    const int large = 16 + (int)(logf((float)n / 16.f) / 2.0794415416798357f * 16.f);
    return large < 31 ? large : 31;
}
#define XB_TMO      128
#define XB_XCNT(j)  (256  + 64 * (j))
#define XB_XSUB(j)  (1280 + 64 * (j))
#define XB_XGEN(j)  (2304 + 64 * (j))
#define XB_TOP      3328
#define XB_TOPGEN   3392
#define XCD_BAR_WORDS 3456
#define XB_SPIN_CAP (1u << 18)

__device__ __forceinline__ unsigned xb_ld(unsigned* p)              { return __hip_atomic_load(p, __ATOMIC_RELAXED, __HIP_MEMORY_SCOPE_AGENT); }
__device__ __forceinline__ unsigned xb_add(unsigned* p, unsigned v) { return __hip_atomic_fetch_add(p, v, __ATOMIC_RELAXED, __HIP_MEMORY_SCOPE_AGENT); }
__device__ __forceinline__ unsigned xb_xcc_id() { return (unsigned)__builtin_amdgcn_s_getreg((3 << 11) | 20) & 0xFu; }
#define XB_SPIN(cond, bar) do { unsigned _sp = 0; while (cond) { __builtin_amdgcn_s_sleep(1); \
    if ((++_sp & 255u) == 0u) { if (xb_ld(&(bar)[XB_TMO])) break; if (_sp > XB_SPIN_CAP) { atomicAdd(&(bar)[XB_TMO], 1u); break; } } } } while (0)

struct XcdBarrier {
    unsigned* bar; unsigned x;
    volatile LAS unsigned* st;
};

__device__ __forceinline__ XcdBarrier xcd_barrier_post(unsigned* bar, volatile LAS unsigned* st) {
    XcdBarrier b; b.bar = bar; b.x = xb_xcc_id(); b.st = st;
    if (threadIdx.x == 0) (void)xb_add(&bar[XB_XCNT(b.x)], 1u);
    return b;
}
__device__ __forceinline__ void xcd_barrier_complete(unsigned* bar, unsigned x, unsigned& nloc, unsigned& nx) {
    const unsigned G = gridDim.x * gridDim.y * gridDim.z;
    unsigned sum, cnt, mine, sp = 0u;
    for (;;) {
        sum = 0u; cnt = 0u; mine = 0u;
#pragma unroll
        for (unsigned j = 0; j < 16; ++j) { const unsigned c = xb_ld(&bar[XB_XCNT(j)]); sum += c; cnt += (c > 0u) ? 1u : 0u; mine = (j == x) ? c : mine; }
        if (sum == G) break;
        __builtin_amdgcn_s_sleep(1);
        if ((++sp & 255u) == 0u) { if (xb_ld(&bar[XB_TMO])) break; if (sp > XB_SPIN_CAP) { atomicAdd(&bar[XB_TMO], 1u); break; } }
    }
    nloc = mine > 0u ? mine : 1u; nx = cnt > 0u ? cnt : 1u;
}

__device__ __forceinline__ void xcd_barrier(const XcdBarrier& b) {
    asm volatile("s_waitcnt vmcnt(0)" ::: "memory");
    __syncthreads();
    if (threadIdx.x == 0) {
        unsigned* bar = b.bar;
        __builtin_amdgcn_s_waitcnt(0);
        unsigned nloc = b.st[0], nx = b.st[1];
        if (nloc == 0u) { xcd_barrier_complete(bar, b.x, nloc, nx); b.st[0] = nloc; b.st[1] = nx; }
        const unsigned old = xb_add(&bar[XB_XSUB(b.x)], 1u);
        const unsigned gen = old / nloc;
        if (old + 1u == (gen + 1u) * nloc) {
            __builtin_amdgcn_fence(__ATOMIC_RELEASE, "agent");
            asm volatile("s_waitcnt vmcnt(0)" ::: "memory");
            const unsigned og = xb_add(&bar[XB_TOP], 1u);
            const unsigned tg = og / nx;
            if (og + 1u == (tg + 1u) * nx) xb_add(&bar[XB_TOPGEN], 1u);
            else XB_SPIN(xb_ld(&bar[XB_TOPGEN]) == tg, bar);
            __builtin_amdgcn_fence(__ATOMIC_ACQUIRE, "agent");
            xb_add(&bar[XB_XGEN(b.x)], 1u);
            asm volatile("s_waitcnt vmcnt(0)" ::: "memory");
        } else {
            XB_SPIN(xb_ld(&bar[XB_XGEN(b.x)]) == gen, bar);
            __builtin_amdgcn_fence(__ATOMIC_ACQUIRE, "agent");
            asm volatile("s_waitcnt vmcnt(0)" ::: "memory");
        }
    }
    __syncthreads();
}

struct Frame {
    LAS unsigned char* lds;
    unsigned char* ldsg;
    volatile LAS unsigned* MISC;
    int tid, lane, wave, vcu, G;
    const float *x, *norm_gain, *final_gain, *rel_bias, *w_in_even, *gla_w_up, *gla_b_up, *gla_gain, *sinks, *w_out_even, *w_in_odd, *w_out_odd;
    float* out;
    unsigned char* ws;
    bf16 *WT0, *WTO0, *WT1, *WTO1, *XN, *MIX, *PROJ, *ST;
    float *LOGA, *KMEAN, *DEC, *KVC, *GO;
};

__device__ __forceinline__ void p0_transpose_item(const float* W, int ldw, int K, bf16* WT, int k0, int n_src0, int n_dst0, LAS float* scr, int lane) {
#pragma unroll 8
    for (int i = 0; i < 32; ++i) { const int kk = 2 * i + (lane >> 5); scr[kk * 33 + (lane & 31)] = W[(size_t)(k0 + kk) * ldw + n_src0 + (lane & 31)]; }
    LDS_WAIT(); asm volatile("" ::: "memory");
    const int c = lane & 7;
#pragma unroll
    for (int j = 0; j < 4; ++j) { const int n = (lane >> 3) + 8 * j; const LAS float* s = scr + (8 * c) * 33 + n;
        v4u o; o.x = pk2(s[0 * 33], s[1 * 33]); o.y = pk2(s[2 * 33], s[3 * 33]); o.z = pk2(s[4 * 33], s[5 * 33]); o.w = pk2(s[6 * 33], s[7 * 33]);
        *(GAS v4u*)(WT + (size_t)(n_dst0 + n) * K + k0 + 8 * c) = o; }
    LDS_WAIT(); asm volatile("" ::: "memory");
}
__device__ __forceinline__ void rms_row_to_bf16(const float* xrow, const float* g, bf16* orow, int lane) {
    const GAS f32x4* xr = (const GAS f32x4*)xrow + lane;
    const GAS f32x4* gr = (const GAS f32x4*)g + lane;
    f32x4 v[4]; float s = 0.f;
#pragma unroll
    for (int j = 0; j < 4; ++j) { v[j] = xr[64 * j]; s += (v[j].x * v[j].x + v[j].y * v[j].y) + (v[j].z * v[j].z + v[j].w * v[j].w); }
    const float rs = 1.0f / sqrtf(wave_sum(s) * (1.f / DM) + EPS);
    GAS unsigned long long* o8 = (GAS unsigned long long*)orow + lane;
#pragma unroll
    for (int j = 0; j < 4; ++j) { const f32x4 gg = gr[64 * j];
        o8[64 * j] = (unsigned long long)pk2(v[j].x * rs * gg.x, v[j].y * rs * gg.y) | ((unsigned long long)pk2(v[j].z * rs * gg.z, v[j].w * rs * gg.w) << 32); }
}
__device__ __forceinline__ void p0_prologue(Frame& F) {
    LAS float* scr = (LAS float*)(F.lds + F.wave * 16384);
    const int gw = F.vcu * NWAVES + F.wave, NGW = F.G * NWAVES;
    constexpr int KB = DM / 64;
    constexpr int I_0 = KB * (N0 / 32), I_O = KB * (DM / 32), I_1 = KB * (N1 / 32);
    constexpr int NITEMS = I_0 + I_O + I_1 + I_O;
    for (int it = gw; it < NITEMS; it += NGW) {
        int r = it;
        if (r < I_0) { const int kb = r / (N0 / 32), nb = r % (N0 / 32), nd = nb * 32, ns = nd + (nd >= 1024 ? 16 : 0);
            p0_transpose_item(F.w_in_even, EC_SRC, DM, F.WT0, kb * 64, ns, nd, scr, F.lane); continue; } r -= I_0;
        if (r < I_O) { const int kb = r / (DM / 32), nb = r % (DM / 32); p0_transpose_item(F.w_out_even, DM, DM, F.WTO0, kb * 64, nb * 32, nb * 32, scr, F.lane); continue; } r -= I_O;
        if (r < I_1) { const int kb = r / (N1 / 32), nb = r % (N1 / 32); p0_transpose_item(F.w_in_odd, OC_SRC, DM, F.WT1, kb * 64, nb * 32, nb * 32, scr, F.lane); continue; } r -= I_1;
        { const int kb = r / (DM / 32), nb = r % (DM / 32); p0_transpose_item(F.w_out_odd, DM, DM, F.WTO1, kb * 64, nb * 32, nb * 32, scr, F.lane); }
    }
    __syncthreads();
    LAS float* WdT = (LAS float*)(F.lds);
    LAS float* Wup = (LAS float*)(F.lds + 65536);
    LAS float* Bup = (LAS float*)(F.lds + 65536 + 16384);
    for (int i = F.tid; i < 16 * 1024; i += NTHR) { const int k = i >> 4, r = i & 15; WdT[r * 1024 + k] = F.w_in_even[(size_t)k * EC_SRC + 1024 + r]; }
    for (int i = F.tid; i < 16 * 256; i += NTHR) Wup[i] = F.gla_w_up[i];
    for (int i = F.tid; i < 256; i += NTHR) Bup[i] = F.gla_b_up[i];
    __syncthreads();
    const int lane = F.lane;
    for (int m = gw; m < M; m += NGW) {
        const GAS f32x4* xr = (const GAS f32x4*)(F.x + (size_t)m * DM) + lane;
        const GAS f32x4* gr = (const GAS f32x4*)F.norm_gain + lane;
        f32x4 v[4]; float s = 0.f;
#pragma unroll
        for (int j = 0; j < 4; ++j) { v[j] = xr[64 * j]; s += (v[j].x * v[j].x + v[j].y * v[j].y) + (v[j].z * v[j].z + v[j].w * v[j].w); }
        const float rs = 1.0f / sqrtf(wave_sum(s) * (1.f / DM) + EPS);
        GAS unsigned long long* o8 = (GAS unsigned long long*)(F.XN + (size_t)m * DM) + lane;
#pragma unroll
        for (int j = 0; j < 4; ++j) { const f32x4 gg = gr[64 * j]; v[j].x *= rs * gg.x; v[j].y *= rs * gg.y; v[j].z *= rs * gg.z; v[j].w *= rs * gg.w;
            o8[64 * j] = (unsigned long long)pk2(v[j].x, v[j].y) | ((unsigned long long)pk2(v[j].z, v[j].w) << 32); }
        f32x4 z = *(const LAS f32x4*)(Bup + 4 * lane);
#pragma unroll 2
        for (int r = 0; r < 16; ++r) { float a = 0.f;
#pragma unroll
            for (int j = 0; j < 4; ++j) { const f32x4 w = *(const LAS f32x4*)(WdT + r * 1024 + 256 * j + 4 * lane); a += (v[j].x * w.x + v[j].y * w.y) + (v[j].z * w.z + v[j].w * w.w); }
            const float ad = wave_sum(a);
            const f32x4 wu = *(const LAS f32x4*)(Wup + r * 256 + 4 * lane); z += ad * wu; }
        f32x4 la;
#pragma unroll
        for (int i = 0; i < 4; ++i) la[i] = (fminf(z[i], 0.f) - log1pf(__expf(-fabsf(z[i])))) * (1.0f / 16.0f);
        *((GAS f32x4*)(F.LOGA + (size_t)m * 256) + lane) = la;
    }
}

__device__ __forceinline__ void p2_gla_naive(Frame& F) {
    for (int u = blockIdx.x; u < 256; u += F.G) {
        const int bh = u >> 5, b = bh >> 2, h = bh & 3, e = (u & 31) * 4 + F.wave, d = F.lane;
        if (F.wave < 4) {
            float st = 0.f;
#pragma unroll 8
            for (int t = 0; t < SEQ; ++t) {
                const size_t row = (size_t)b * SEQ + t;
                const bf16* pr = F.PROJ + row * N0;
                const float q = bf2f(pr[P0_AQ + h * 64 + d]), k = bf2f(pr[P0_AK + h * 64 + d]), v = bf2f(pr[P0_AV + h * 128 + e]);
                const float alpha = __expf(F.LOGA[row * 256 + h * 64 + d]);
                st = alpha * st + k * v;
                const float o = wave_sum(q * st);
                if (d == 0) F.GO[row * 512 + h * 128 + e] = o;
            }
        }
    }
}
__device__ __forceinline__ void p4_gla_post_naive(Frame& F) {
    const int gw = F.vcu * NWAVES + F.wave, NGW = F.G * NWAVES, lane = F.lane;
    for (int it = gw; it < M * 4; it += NGW) {
        const int row = it >> 2, h = it & 3;
        const float* o = F.GO + (size_t)row * 512 + h * 128;
        const float a = o[lane], c = o[lane + 64];
        const float rs = 1.0f / sqrtf(wave_sum(a * a + c * c) * (1.0f / 128.f) + EPS);
        const bf16* g = F.PROJ + (size_t)row * N0 + P0_AG + h * 128;
        bf16* mo = F.MIX + (size_t)row * DM + h * 128;
        mo[lane] = (bf16)f2bf(a * rs * F.gla_gain[lane] * silu_f(bf2f(g[lane])));
        mo[lane + 64] = (bf16)f2bf(c * rs * F.gla_gain[lane + 64] * silu_f(bf2f(g[lane + 64])));
    }
}
__device__ __forceinline__ void p3_swa_naive(Frame& F) {
    for (int gid = blockIdx.x * NTHR + F.tid; gid < M * 8; gid += F.G * NTHR) {
        const int h = gid & 7, row = gid >> 3, b = row / SEQ, t = row % SEQ, kvh = h >> 2;
        const bf16* pr = F.PROJ + (size_t)row * N0;
        float q[64];
#pragma unroll
        for (int i = 0; i < 64; ++i) q[i] = bf2f(pr[P0_BQ + h * 64 + i]);
        float m = F.sinks[h] * LOG2E, l = 1.f, o[64];
#pragma unroll
        for (int i = 0; i < 64; ++i) o[i] = 0.f;
        const int j0 = t - 127 > 0 ? t - 127 : 0;
        for (int j = j0; j <= t; ++j) {
            const bf16* kr = F.PROJ + (size_t)(b * SEQ + j) * N0 + P0_BK + kvh * 64;
            const bf16* vr = F.PROJ + (size_t)(b * SEQ + j) * N0 + P0_BV + kvh * 64;
            float s = 0.f;
#pragma unroll
            for (int i = 0; i < 64; ++i) s += q[i] * bf2f(kr[i]);
            s += F.rel_bias[t5_bucket(t - j) * 8 + h] * LOG2E;
            const float mn = fmaxf(m, s), f = exp2f(m - mn), p = exp2f(s - mn);
            l = l * f + p; m = mn;
#pragma unroll
            for (int i = 0; i < 64; ++i) o[i] = o[i] * f + p * bf2f(vr[i]);
        }
        const float inv = 1.f / l;
#pragma unroll
        for (int i = 0; i < 64; ++i) F.MIX[(size_t)row * DM + 512 + h * 64 + i] = (bf16)f2bf(o[i] * inv * silu_f(bf2f(pr[P0_BG + h * 64 + i])));
    }
}
__device__ __forceinline__ void p8_kmean_naive(Frame& F) {
    for (int gid = blockIdx.x * NTHR + F.tid; gid < 128 * 128; gid += F.G * NTHR) {
        const int item = gid >> 7, d = gid & 127, n = item & 31, bk = item >> 5, b = bk >> 1, kvh = bk & 1;
        float s = 0.f;
        for (int r = 0; r < 256; ++r) s += bf2f(F.PROJ[(size_t)(b * SEQ + n * 256 + r) * N1 + P1_CK + kvh * 128 + d]);
        F.KMEAN[(size_t)item * 128 + d] = s * (1.0f / 256.f);
    }
}
__device__ __forceinline__ void p9_moba_naive(Frame& F) {
    LAS float* qs = (LAS float*)(F.lds) + F.wave * 128;
    const int gw = F.vcu * NWAVES + F.wave, NGW = F.G * NWAVES, lane = F.lane;
    for (int item = gw; item < M * 8; item += NGW) {
        const int h = item & 7, row = item >> 3, b = row / SEQ, t = row % SEQ, kvh = h >> 2, own = t >> 8;
        const bf16* pr = F.PROJ + (size_t)row * N1;
        LDS_WAIT();
        qs[lane] = bf2f(pr[P1_CQ + h * 128 + lane]); qs[lane + 64] = bf2f(pr[P1_CQ + h * 128 + lane + 64]);
        LDS_WAIT(); asm volatile("" ::: "memory");
        const LAS f32x4* q4 = (const LAS f32x4*)qs;
        float gate = -INFINITY;
        if (lane < own) { const GAS f32x4* km = (const GAS f32x4*)(F.KMEAN + ((size_t)((b * 2 + kvh) * 32 + lane)) * 128); float s = 0.f;
            for (int i = 0; i < 32; ++i) { const f32x4 a = q4[i], c = km[i]; s += (a.x * c.x + a.y * c.y) + (a.z * c.z + a.w * c.w); } gate = s; }
        int s0 = -1, s1 = -1, s2 = -1;
#pragma unroll
        for (int r = 0; r < 3; ++r) {
            const float mx = wave_max(gate);
            int idx = -1;
            if (mx != -INFINITY) { const unsigned long long bal = __ballot(gate == mx); idx = __ffsll((long long)bal) - 1; if (lane == idx) gate = -INFINITY; }
            if (r == 0) s0 = idx; else if (r == 1) s1 = idx; else s2 = idx;
        }
        float m = -INFINITY, l = 0.f, o0 = 0.f, o1 = 0.f;
        for (int si = 0; si < 4; ++si) {
            const int blk = si == 0 ? s0 : (si == 1 ? s1 : (si == 2 ? s2 : own));
            if (blk < 0) continue;
            for (int c = 0; c < 4; ++c) {
                const int kpos = blk * 256 + c * 64 + lane;
                float s = -INFINITY;
                if (kpos <= t) {
                    const GAS v4u* kr = (const GAS v4u*)(F.PROJ + (size_t)(b * SEQ + kpos) * N1 + P1_CK + kvh * 128);
                    float a = 0.f;
                    for (int i = 0; i < 16; ++i) { const v4u kk = kr[i]; const f32x4 qa = q4[2 * i], qb = q4[2 * i + 1];
                        a += (qa.x * bflo(kk.x) + qa.y * bfhi(kk.x)) + (qa.z * bflo(kk.y) + qa.w * bfhi(kk.y)) + (qb.x * bflo(kk.z) + qb.y * bfhi(kk.z)) + (qb.z * bflo(kk.w) + qb.w * bfhi(kk.w)); }
                    s = a + F.rel_bias[t5_bucket(t - kpos) * 8 + h] * LOG2E;
                }
                const float cm = wave_max(s);
                if (cm == -INFINITY) continue;
                const float mn = fmaxf(m, cm), f = exp2f(m - mn), p = exp2f(s - mn);
                l = l * f + wave_sum(p); m = mn; o0 *= f; o1 *= f;
                for (int j = 0; j < 64; ++j) {
                    const float pj = __shfl(p, j);
                    const unsigned vv = *(const GAS unsigned*)(F.PROJ + (size_t)(b * SEQ + blk * 256 + c * 64 + j) * N1 + P1_CV + kvh * 128 + 2 * lane);
                    o0 += pj * bflo(vv); o1 += pj * bfhi(vv);
                }
            }
        }
        const float inv = 1.f / l;
        const unsigned gg = *(const GAS unsigned*)(pr + P1_CG + h * 128 + 2 * lane);
        *(GAS unsigned*)(F.MIX + (size_t)row * DM + h * 128 + 2 * lane) = pk2(o0 * inv * silu_f(bflo(gg)), o1 * inv * silu_f(bfhi(gg)));
    }
}
__device__ __forceinline__ void p_rms_rows_bf16(Frame& F, const float* src, const float* g, bf16* dst) {
    const int gw = F.vcu * NWAVES + F.wave, NGW = F.G * NWAVES;
    for (int m = gw; m < M; m += NGW) rms_row_to_bf16(src + (size_t)m * DM, g, dst + (size_t)m * DM, F.lane);
}
__device__ __forceinline__ void p_rms_rows_f32_inplace(Frame& F, float* buf, const float* g) {
    const int gw = F.vcu * NWAVES + F.wave, NGW = F.G * NWAVES, lane = F.lane;
    for (int m = gw; m < M; m += NGW) {
        GAS f32x4* xr = (GAS f32x4*)(buf + (size_t)m * DM) + lane;
        const GAS f32x4* gr = (const GAS f32x4*)g + lane;
        f32x4 v[4]; float s = 0.f;
#pragma unroll
        for (int j = 0; j < 4; ++j) { v[j] = xr[64 * j]; s += (v[j].x * v[j].x + v[j].y * v[j].y) + (v[j].z * v[j].z + v[j].w * v[j].w); }
        const float rs = 1.0f / sqrtf(wave_sum(s) * (1.f / DM) + EPS);
#pragma unroll
        for (int j = 0; j < 4; ++j) { const f32x4 gg = gr[64 * j]; f32x4 o; o.x = v[j].x * rs * gg.x; o.y = v[j].y * rs * gg.y; o.z = v[j].z * rs * gg.z; o.w = v[j].w * rs * gg.w; xr[64 * j] = o; }
    }
}

struct Args { const float* in[12]; float* out; unsigned char* ws; };
template <int LO, int HI>
__global__ void __launch_bounds__(NTHR, 2) fwd_kernel(Args args) {
    extern __shared__ __attribute__((aligned(16))) unsigned char lds[];
    Frame F;
    F.lds = (LAS unsigned char*)lds; F.ldsg = lds;
    F.MISC = (volatile LAS unsigned*)(F.lds + MISC_OFF);
    F.tid = threadIdx.x; F.lane = F.tid & 63; F.wave = __builtin_amdgcn_readfirstlane(F.tid >> 6);
    F.G = gridDim.x; { const int bx = blockIdx.x; F.vcu = (F.G % 8 == 0) ? (bx % 8) * (F.G / 8) + bx / 8 : bx; }
    F.x = args.in[0]; F.norm_gain = args.in[1]; F.final_gain = args.in[2]; F.rel_bias = args.in[3]; F.w_in_even = args.in[4]; F.gla_w_up = args.in[5];
    F.gla_b_up = args.in[6]; F.gla_gain = args.in[7]; F.sinks = args.in[8]; F.w_out_even = args.in[9]; F.w_in_odd = args.in[10]; F.w_out_odd = args.in[11];
    F.out = args.out; F.ws = args.ws;
    unsigned char* ws = args.ws;
    F.WT0 = (bf16*)(ws + WS_WT0); F.WTO0 = (bf16*)(ws + WS_WTO0); F.WT1 = (bf16*)(ws + WS_WT1); F.WTO1 = (bf16*)(ws + WS_WTO1);
    F.XN = (bf16*)(ws + WS_XN); F.MIX = (bf16*)(ws + WS_MIX); F.PROJ = (bf16*)(ws + WS_PROJ); F.ST = (bf16*)(ws + WS_ST);
    F.LOGA = (float*)(ws + WS_LOGA); F.KMEAN = (float*)(ws + WS_KMEAN); F.DEC = (float*)(ws + WS_DEC);
    F.KVC = (float*)((unsigned char*)args.out + DO_KVC); F.GO = (float*)((unsigned char*)args.out + DO_GO);
    for (int u = F.tid; u < (LDS_BYTES - LDSCTL_OFF) / 4; u += NTHR) ((LAS unsigned*)(F.lds + LDSCTL_OFF))[u] = 0u;
    __syncthreads();
    constexpr bool MULTI = (HI - LO) > 1;
    XcdBarrier bar; bar.bar = (unsigned*)(ws + WS_CTL) + CW_BAR; bar.x = 0; bar.st = nullptr;
    if (MULTI) bar = xcd_barrier_post((unsigned*)(ws + WS_CTL) + CW_BAR, F.MISC + 8);
#define IN(k) (LO <= (k) && (k) < HI)
#define SEAM(k) do { if (IN(k) && IN((k) + 1)) xcd_barrier(bar); } while (0)

    if constexpr (IN(0)) { p0_prologue(F); SEAM(0); }
    if constexpr (IN(1)) {
        pg8::Gemm g{F.XN, F.WT0, M, N0, DM}; pg8::StaticOrder S; S.init(M, N0, F.G, (int)blockIdx.x);
        pg8::EpiProj E{F.PROJ, N0, 0x001u, 0.125f, 0x0C0u, 0.125f * LOG2E};
        pg8::gemm_phase<pg8::EpiProj, pg8::StaticOrder, true, true>(F.lds, g, S, E);
        SEAM(1);
    }
    if constexpr (IN(2)) { p2_gla_naive(F); SEAM(2); }
    if constexpr (IN(3)) { p3_swa_naive(F); SEAM(3); }
    if constexpr (IN(4)) { p4_gla_post_naive(F); SEAM(4); }
    if constexpr (IN(5)) {
        pg8::Gemm g{F.MIX, F.WTO0, M, DM, DM}; pg8::StaticOrder S; S.init(M, DM, F.G, (int)blockIdx.x);
        pg8::EpiRes E{F.x, F.out, DM};
        pg8::gemm_phase<pg8::EpiRes, pg8::StaticOrder, false, true>(F.lds, g, S, E);
        SEAM(5);
    }
    if constexpr (IN(6)) { p_rms_rows_bf16(F, F.out, F.norm_gain + DM, F.XN); SEAM(6); }
    if constexpr (IN(7)) {
        pg8::Gemm g{F.XN, F.WT1, M, N1, DM}; pg8::StaticOrder S; S.init(M, N1, F.G, (int)blockIdx.x);
        pg8::EpiProj E{F.PROJ, N1, 0x00Fu, 0.08838834764831845f * LOG2E, 0u, 1.f};
        pg8::gemm_phase<pg8::EpiProj, pg8::StaticOrder, true, true>(F.lds, g, S, E);
        SEAM(7);
    }
    if constexpr (IN(8)) { p8_kmean_naive(F); SEAM(8); }
    if constexpr (IN(9)) { p9_moba_naive(F); SEAM(9); }
    if constexpr (IN(10)) {
        pg8::Gemm g{F.MIX, F.WTO1, M, DM, DM}; pg8::StaticOrder S; S.init(M, DM, F.G, (int)blockIdx.x);
        pg8::EpiRes E{F.out, F.out, DM};
        pg8::gemm_phase<pg8::EpiRes, pg8::StaticOrder, false, true>(F.lds, g, S, E);
        SEAM(10);
    }
    if constexpr (IN(11)) { p_rms_rows_f32_inplace(F, F.out, F.final_gain); }
#undef IN
#undef SEAM
}

template <int LO, int HI>
static void launch_range(const Args& a, int grid, hipStream_t stream) {
    static bool attr_done = false;
    if (!attr_done) { (void)hipFuncSetAttribute((const void*)fwd_kernel<LO, HI>, hipFuncAttributeMaxDynamicSharedMemorySize, LDS_BYTES); attr_done = true; }
    hipLaunchKernelGGL((fwd_kernel<LO, HI>), dim3(grid), dim3(NTHR), LDS_BYTES, stream, a);
}
#ifndef ONE_LAUNCH
#define ONE_LAUNCH 1
#endif
extern "C" void kernel_launch(void* const* d_in, const int* in_sizes, int n_in, void* d_out, int out_size, void* d_ws, size_t ws_size, hipStream_t stream) {
    static int grid = 0;
    if (grid == 0) {
        int dev = 0, cus = 0;
        if (hipGetDevice(&dev) != hipSuccess || hipDeviceGetAttribute(&cus, hipDeviceAttributeMultiprocessorCount, dev) != hipSuccess) { fprintf(stderr, "kernel_launch: device query failed\n"); grid = -1; return; }
        if (n_in != 12 || ws_size < WS_END) { fprintf(stderr, "kernel_launch: unexpected inputs / workspace\n"); grid = -1; return; }
        grid = cus;
    }
    if (grid < 0) return;
    (void)hipMemsetAsync((char*)d_ws + WS_CTL, 0, CTL_ZERO_BYTES, stream);
    Args a{};
    for (int i = 0; i < 12; ++i) a.in[i] = (const float*)d_in[i];
    a.out = (float*)d_out; a.ws = (unsigned char*)d_ws;
#if ONE_LAUNCH
    launch_range<0, NPHASE>(a, grid, stream);
#else
    launch_range<0, 1>(a, grid, stream); launch_range<1, 2>(a, grid, stream); launch_range<2, 3>(a, grid, stream); launch_range<3, 4>(a, grid, stream);
    launch_range<4, 5>(a, grid, stream); launch_range<5, 6>(a, grid, stream); launch_range<6, 7>(a, grid, stream); launch_range<7, 8>(a, grid, stream);
    launch_range<8, 9>(a, grid, stream); launch_range<9, 10>(a, grid, stream); launch_range<10, 11>(a, grid, stream); launch_range<11, 12>(a, grid, stream);
#endif
}
```

```cpp
#include <hip/hip_runtime.h>
#include <cstdio>
#include <cstdint>
#include <math.h>
namespace pg8 {
#define PG8_LAS __attribute__((address_space(3)))
typedef unsigned short bf16_t;
typedef short bf16x8 __attribute__((ext_vector_type(8)));
typedef float f32x4 __attribute__((ext_vector_type(4)));
typedef unsigned u32x4 __attribute__((ext_vector_type(4)));
constexpr int BM = 256, BK = 64, HALF = 128, HTB = HALF * BK * 2  , STAGE_BYTES = 8 * HTB, NXCD = 8, WGM = 8;

__host__ __device__ __forceinline__ int lds_byte(int r, int c) { const int st = (r >> 4) * 2 + (c >> 5), rr = r & 15, cc = c & 31, ob = rr * 64 + cc * 2; return st * 1024 + (ob ^ (((ob >> 9) & 1) << 5)); }
__host__ __device__ __forceinline__ void stage_rc(int b, int& R, int& C) { const int st = b / 1024, sb = b % 1024, swz = sb ^ (((sb >> 9) & 1) << 5); R = (st >> 1) * 16 + swz / 64; C = (st & 1) * 32 + (swz % 64) / 2; }
__host__ __device__ __forceinline__ int perm32(int rho) { const int n = rho >> 4, i = rho & 15; return 8 * (i >> 2) + 4 * n + (i & 3); }

struct Unit { int pm, pn; };
struct Gemm { const bf16_t* A; const bf16_t* Bt; int M, N, K; };

struct StaticOrder {
    int nM, nN, nwg, G, c;
    __host__ __device__ void init(int M, int N, int G_, int c_) { nM = M / BM; nN = N / BM; nwg = nM * nN; G = G_; c = c_; }
    __host__ __device__ bool next(int i, Unit& u) const {
        const long L = (long)i * G + c; if (L >= nwg) return false;
        int wgid = (int)L; { const int q = nwg / NXCD, r = nwg % NXCD, xcd = wgid % NXCD, off = wgid / NXCD; wgid = (xcd < r ? xcd * (q + 1) : r * (q + 1) + (xcd - r) * q) + off; }
        const int nig = WGM * nN, gid = wgid / nig, fm = gid * WGM, gsz = (nM - fm) < WGM ? (nM - fm) : WGM;
        u.pm = fm + ((wgid % nig) % gsz); u.pn = (wgid % nig) / gsz; return true;
    }
    __device__ __forceinline__ void a_ready(const Unit&) const {}
    __device__ __forceinline__ void done(const Unit&) const {}
};

__device__ __forceinline__ unsigned cvt_pk_bf16(float lo, float hi) { unsigned r; asm volatile("v_cvt_pk_bf16_f32 %0, %1, %2" : "=v"(r) : "v"(lo), "v"(hi)); return r; }
typedef float f32x2 __attribute__((ext_vector_type(2)));
typedef unsigned u32x4 __attribute__((ext_vector_type(4)));
struct EpiProj {
    static constexpr bool PERM = true, AFTER_DRAIN = false;
    bf16_t* O; int ldc; unsigned maskA; float sA; unsigned maskB; float sB;
    __device__ __forceinline__ void operator()(const f32x4 (&acc)[2][2][4][2], const Unit& u, int wr, int wc, int fr, int fq) const {
        const float sc = ((maskA >> u.pn) & 1u) ? sA : (((maskB >> u.pn) & 1u) ? sB : 1.f);
        const int row0 = u.pm * BM + wr * 64 + fr, col0 = u.pn * BM + wc * 32 + 8 * fq;
#pragma unroll
        for (int ai = 0; ai < 2; ++ai)
#pragma unroll
            for (int m = 0; m < 4; ++m) { bf16_t* rowp = O + (size_t)(row0 + ai * HALF + m * 16) * ldc + col0;
#pragma unroll
                for (int bj = 0; bj < 2; ++bj) { const f32x4 v0 = acc[ai][bj][m][0] * sc, v1 = acc[ai][bj][m][1] * sc;
                    u32x4 w; w.x = cvt_pk_bf16(v0[0], v0[1]); w.y = cvt_pk_bf16(v0[2], v0[3]); w.z = cvt_pk_bf16(v1[0], v1[1]); w.w = cvt_pk_bf16(v1[2], v1[3]);
                    *(u32x4*)(rowp + bj * HALF) = w; } }
    }
};
struct EpiRes {
    static constexpr bool PERM = false, AFTER_DRAIN = false;
    const float* base; float* out; int ldc;
    __device__ __forceinline__ void operator()(const f32x4 (&acc)[2][2][4][2], const Unit& u, int wr, int wc, int fr, int fq) const {
        const int col0 = u.pn * BM + wc * 32 + 4 * fq;
#pragma unroll
        for (int ai = 0; ai < 2; ++ai)
#pragma unroll
            for (int m = 0; m < 4; ++m) { const size_t off = (size_t)(u.pm * BM + ai * HALF + wr * 64 + m * 16 + fr) * ldc + col0;
#pragma unroll
                for (int bj = 0; bj < 2; ++bj)
#pragma unroll
                    for (int n = 0; n < 2; ++n) { const f32x4 bs = *(const f32x4*)(base + off + bj * HALF + n * 16); *(f32x4*)(out + off + bj * HALF + n * 16) = bs + acc[ai][bj][m][n]; } }
    }
};
template <class Epi, class Sched, bool ALIGN_EPI = false, bool SP2 = false>
__device__ __forceinline__ void gemm_phase(PG8_LAS unsigned char* lds, const Gemm g, const Sched& S, const Epi& E) {
    const int tid = threadIdx.x, wid = __builtin_amdgcn_readfirstlane(tid >> 6), lane = tid & 63, wr = wid >> 2, wc = wid & 3, fr = lane & 15, fq = lane >> 4;
    const int K = g.K, nt = K / BK;
    unsigned voffA[2], voffB[2];
#pragma unroll
    for (int i = 0; i < 2; ++i) { int R, C; stage_rc(tid * 16 + i * 8192, R, C); const int Rb = Epi::PERM ? ((R & ~31) + perm32(R & 31)) : R;
        voffA[i] = (unsigned)(R * K + C) * 2u; voffB[i] = (unsigned)(Rb * K + C) * 2u; }
    const size_t kstep = (size_t)(BK * 2);
    const size_t hstep = (size_t)HALF * K * 2;
    const size_t tstep = 2 * hstep;
    const unsigned ldsw = (unsigned)wid * 1024u;
    const int aoff = lds_byte(wr * 64 + fr, fq * 8), boff = lds_byte(wc * 32 + fr, fq * 8);
#define PG8_SA(b, h) (((b) * 2 + (h)) * HTB)
#define PG8_SB(b, h) ((4 + (b) * 2 + (h)) * HTB)
#define PG8_STAGE(bufoff, gbase, voff) do { _Pragma("unroll") for (int _i = 0; _i < 2; ++_i) \
        __builtin_amdgcn_global_load_lds((const unsigned*)((const char*)(gbase) + (voff)[_i]), (PG8_LAS unsigned*)(lds + (bufoff) + ldsw + _i * 8192), 16, 0, 0); } while (0)
#define PG8_LDA(dst, b, h) do { _Pragma("unroll") for (int m = 0; m < 4; ++m) _Pragma("unroll") for (int k = 0; k < 2; ++k) dst[m][k] = *(const PG8_LAS bf16x8*)(lds + PG8_SA(b, h) + aoff + m * 2048 + k * 1024); } while (0)
#define PG8_LDB(dst, b, h) do { _Pragma("unroll") for (int n = 0; n < 2; ++n) _Pragma("unroll") for (int k = 0; k < 2; ++k) dst[n][k] = *(const PG8_LAS bf16x8*)(lds + PG8_SB(b, h) + boff + n * 2048 + k * 1024); } while (0)
#define PG8_MMA(ai, bj, At, Bt) do { __builtin_amdgcn_s_setprio(1); _Pragma("unroll") for (int m = 0; m < 4; ++m) _Pragma("unroll") for (int n = 0; n < 2; ++n) _Pragma("unroll") for (int k = 0; k < 2; ++k) \
        acc[ai][bj][m][n] = __builtin_amdgcn_mfma_f32_16x16x32_bf16(Bt[n][k], At[m][k], acc[ai][bj][m][n], 0, 0, 0); __builtin_amdgcn_s_setprio(0); } while (0)
#define PG8_WAIT_V(n) asm volatile("s_waitcnt vmcnt(" #n ")" ::: "memory")
#define PG8_WAIT_L(n) asm volatile("s_waitcnt lgkmcnt(" #n ")" ::: "memory")
#define PG8_BAR __builtin_amdgcn_s_barrier()
#define PG8_SCHED __builtin_amdgcn_sched_barrier(0)
    Unit cur, nxt; int ui = 0;
    if (!S.next(0, cur)) return;
    f32x4 acc[2][2][4][2];
#pragma unroll
    for (int a = 0; a < 2; ++a)
#pragma unroll
        for (int b = 0; b < 2; ++b)
#pragma unroll
            for (int m = 0; m < 4; ++m)
#pragma unroll
                for (int n = 0; n < 2; ++n) acc[a][b][m][n] = (f32x4){0.f, 0.f, 0.f, 0.f};
    bf16x8 At[4][2], B0[2][2], B1[2][2];
    const char* cA = (const char*)g.A + (size_t)cur.pm * tstep; const char* cB = (const char*)g.Bt + (size_t)cur.pn * tstep;
    S.a_ready(cur);
    if constexpr (SP2) {
        PG8_STAGE(PG8_SB(0, 0), cB, voffB); PG8_STAGE(PG8_SB(0, 1), cB + hstep, voffB); PG8_STAGE(PG8_SA(0, 0), cA, voffA); PG8_STAGE(PG8_SA(0, 1), cA + hstep, voffA);
        if (wr == 1) PG8_BAR;
        PG8_WAIT_V(2); PG8_BAR;
        PG8_STAGE(PG8_SB(1, 0), cB + kstep, voffB); PG8_STAGE(PG8_SA(1, 0), cA + kstep, voffA); PG8_STAGE(PG8_SB(1, 1), cB + hstep + kstep, voffB);
        PG8_WAIT_V(6); PG8_BAR;
    } else {
        PG8_STAGE(PG8_SB(0, 0), cB, voffB); PG8_STAGE(PG8_SA(0, 0), cA, voffA); PG8_STAGE(PG8_SB(0, 1), cB + hstep, voffB); PG8_STAGE(PG8_SA(0, 1), cA + hstep, voffA);
        if (wr == 1) PG8_BAR;
        PG8_WAIT_V(4); PG8_BAR;
        PG8_STAGE(PG8_SB(1, 0), cB + kstep, voffB); PG8_STAGE(PG8_SA(1, 0), cA + kstep, voffA); PG8_STAGE(PG8_SB(1, 1), cB + hstep + kstep, voffB);
        PG8_WAIT_V(6); PG8_BAR;
    }
    for (;;) {
        const bool has_next = S.next(ui + 1, nxt);
        const char* nA = has_next ? (const char*)g.A + (size_t)nxt.pm * tstep : cA; const char* nB = has_next ? (const char*)g.Bt + (size_t)nxt.pn * tstep : cB;
        for (int t = 0; t < nt; t += 2) {
            const bool last = (t == nt - 2);
            const char* a1 = cA + (size_t)(t + 1) * kstep;
            const char* a2 = last ? nA : cA + (size_t)(t + 2) * kstep; const char* b2 = last ? nB : cB + (size_t)(t + 2) * kstep;
            const char* a3 = a2 + kstep; const char* b3 = b2 + kstep;
            if (last && has_next) S.a_ready(nxt);
            if constexpr (SP2) {
            PG8_LDB(B0, 0, 0); PG8_LDB(B1, 0, 1); PG8_SCHED; PG8_LDA(At, 0, 0); PG8_STAGE(PG8_SA(1, 1), a1 + hstep, voffA);
            PG8_WAIT_V(8); PG8_WAIT_L(0); PG8_BAR; PG8_MMA(0, 0, At, B0); PG8_MMA(0, 1, At, B1); PG8_BAR; PG8_SCHED;
            PG8_LDA(At, 0, 1); PG8_STAGE(PG8_SB(0, 0), b2, voffB); PG8_STAGE(PG8_SB(0, 1), b2 + hstep, voffB); PG8_STAGE(PG8_SA(0, 0), a2, voffA);
            PG8_WAIT_V(8); PG8_WAIT_L(0); PG8_BAR; PG8_MMA(1, 0, At, B0); PG8_MMA(1, 1, At, B1); PG8_BAR; PG8_SCHED;
            PG8_LDB(B0, 1, 0); PG8_LDB(B1, 1, 1); PG8_SCHED; PG8_LDA(At, 1, 0); PG8_STAGE(PG8_SA(0, 1), a2 + hstep, voffA);
            PG8_WAIT_V(8); PG8_WAIT_L(0); PG8_BAR; PG8_MMA(0, 0, At, B0); PG8_MMA(0, 1, At, B1); PG8_BAR; PG8_SCHED;
            PG8_LDA(At, 1, 1); PG8_STAGE(PG8_SB(1, 0), b3, voffB); PG8_STAGE(PG8_SB(1, 1), b3 + hstep, voffB); PG8_STAGE(PG8_SA(1, 0), a3, voffA);
            PG8_WAIT_V(8); PG8_WAIT_L(0); PG8_BAR; PG8_MMA(1, 0, At, B0); PG8_MMA(1, 1, At, B1); PG8_BAR; PG8_SCHED;
            } else {
            PG8_LDB(B0, 0, 0); PG8_SCHED; PG8_LDA(At, 0, 0); PG8_STAGE(PG8_SA(1, 1), a1 + hstep, voffA);
            PG8_WAIT_L(8); PG8_BAR; PG8_WAIT_L(0); PG8_MMA(0, 0, At, B0); PG8_BAR; PG8_SCHED;
            PG8_LDB(B1, 0, 1); PG8_STAGE(PG8_SB(0, 0), b2, voffB);
            PG8_BAR; PG8_WAIT_L(0); PG8_MMA(0, 1, At, B1); PG8_BAR;
            PG8_LDA(At, 0, 1); PG8_STAGE(PG8_SA(0, 0), a2, voffA);
            PG8_BAR; PG8_WAIT_L(0); PG8_MMA(1, 0, At, B0); PG8_BAR; PG8_SCHED;
            PG8_STAGE(PG8_SB(0, 1), b2 + hstep, voffB);
            PG8_WAIT_V(6); PG8_BAR; PG8_MMA(1, 1, At, B1); PG8_BAR;
            PG8_LDB(B0, 1, 0); PG8_SCHED; PG8_LDA(At, 1, 0); PG8_STAGE(PG8_SA(0, 1), a2 + hstep, voffA);
            PG8_WAIT_L(8); PG8_BAR; PG8_WAIT_L(0); PG8_MMA(0, 0, At, B0); PG8_BAR; PG8_SCHED;
            PG8_LDB(B1, 1, 1); PG8_STAGE(PG8_SB(1, 0), b3, voffB);
            PG8_BAR; PG8_WAIT_L(0); PG8_MMA(0, 1, At, B1); PG8_BAR;
            PG8_LDA(At, 1, 1); PG8_STAGE(PG8_SA(1, 0), a3, voffA);
            PG8_BAR; PG8_WAIT_L(0); PG8_MMA(1, 0, At, B0); PG8_BAR; PG8_SCHED;
            PG8_STAGE(PG8_SB(1, 1), b3 + hstep, voffB);
            PG8_WAIT_V(6); PG8_BAR; PG8_MMA(1, 1, At, B1); PG8_BAR;
            }
        }
        if constexpr (ALIGN_EPI) { if (wr == 0) PG8_BAR; }
        if constexpr (!Epi::AFTER_DRAIN) { E(acc, cur, wr, wc, fr, fq); S.done(cur); }
        if (!has_next) break;
#pragma unroll
        for (int a = 0; a < 2; ++a)
#pragma unroll
            for (int b = 0; b < 2; ++b)
#pragma unroll
                for (int m = 0; m < 4; ++m)
#pragma unroll
                    for (int n = 0; n < 2; ++n) acc[a][b][m][n] = (f32x4){0.f, 0.f, 0.f, 0.f};
        cur = nxt; cA = nA; cB = nB; ++ui;
        if constexpr (ALIGN_EPI) { if (wr == 1) PG8_BAR; }
    }
    PG8_WAIT_V(0);
    if constexpr (!ALIGN_EPI) { if (wr == 0) PG8_BAR; }
    PG8_BAR;
    if constexpr (Epi::AFTER_DRAIN) { E.fused(acc, cur, wr, wc, fr, fq, lds, wid, lane); S.done(cur); }
#undef PG8_SA
#undef PG8_SB
#undef PG8_STAGE
#undef PG8_LDA
#undef PG8_LDB
#undef PG8_MMA
#undef PG8_WAIT_V
#undef PG8_WAIT_L
#undef PG8_BAR
#undef PG8_SCHED
}
}

constexpr int NWAVES = 8, NTHR = 512;
constexpr int NB = 2, SEQ = 8192, DM = 1024, M = NB * SEQ;
constexpr int EC_SRC = 2832, OC_SRC = 2560, N0 = 2816, N1 = 2560;
constexpr int P0_AQ = 0, P0_AK = 256, P0_AV = 512, P0_AG = 1024, P0_BQ = 1536, P0_BK = 2048, P0_BV = 2176, P0_BG = 2304;
constexpr int P1_CQ = 0, P1_CK = 1024, P1_CV = 1280, P1_CG = 1536;
constexpr float LOG2E = 1.4426950408889634f;
constexpr float EPS = 1e-6f;
constexpr int NPHASE = 12;

constexpr size_t MiB = 1u << 20;
constexpr size_t WS_CTL = 0, CTL_ZERO_BYTES = 64 * 1024;
constexpr size_t WS_KMEAN = 1 * MiB;
constexpr size_t WS_DEC = 1 * MiB + 128 * 1024;
constexpr size_t WS_WT0 = 2 * MiB, WS_WTO0 = 8 * MiB, WS_WT1 = 10 * MiB, WS_WTO1 = 15 * MiB;
constexpr size_t WS_LOGA = 17 * MiB;
constexpr size_t WS_XN = 33 * MiB;
constexpr size_t WS_MIX = 65 * MiB;
constexpr size_t WS_PROJ = 97 * MiB;
constexpr size_t WS_ST = 185 * MiB;
constexpr size_t WS_END = 201 * MiB;
constexpr size_t DO_KVC = 0;
constexpr size_t DO_GO = 32 * MiB;
constexpr int CW_BAR = 1024;

constexpr int RING_BYTES = 131072;
constexpr int LDSCTL_OFF = RING_BYTES, MISC_OFF = LDSCTL_OFF + 320;
constexpr int LDS_BYTES = 147456;

#define GAS __attribute__((address_space(1)))
#define LAS __attribute__((address_space(3)))
typedef unsigned short bf16;
typedef unsigned v4u __attribute__((ext_vector_type(4)));
typedef unsigned v2u __attribute__((ext_vector_type(2)));
typedef float f32x4 __attribute__((ext_vector_type(4)));
typedef float f32x16 __attribute__((ext_vector_type(16)));
typedef short bf16x8 __attribute__((ext_vector_type(8)));
typedef GAS unsigned gu32;
#define RLX_AGENT __ATOMIC_RELAXED, __HIP_MEMORY_SCOPE_AGENT
#define LDS_WAIT() asm volatile("s_waitcnt lgkmcnt(0)" ::: "memory")
#define VM_WAIT() asm volatile("s_waitcnt vmcnt(0)" ::: "memory")
__device__ __forceinline__ unsigned f2bf(float f) { unsigned u = __builtin_bit_cast(unsigned, f); return (u + 0x7fffu + ((u >> 16) & 1u)) >> 16; }
__device__ __forceinline__ unsigned pk2(float lo, float hi) { return f2bf(lo) | (f2bf(hi) << 16); }
__device__ __forceinline__ float bf2f(bf16 v) { return __builtin_bit_cast(float, (unsigned)v << 16); }
__device__ __forceinline__ float bflo(unsigned w) { return __builtin_bit_cast(float, w << 16); }
__device__ __forceinline__ float bfhi(unsigned w) { return __builtin_bit_cast(float, w & 0xffff0000u); }
__device__ __forceinline__ float wave_sum(float v) {
#pragma unroll
    for (int o = 1; o < 64; o <<= 1) v += __shfl_xor(v, o);
    return v;
}
__device__ __forceinline__ float wave_max(float v) {
#pragma unroll
    for (int o = 1; o < 64; o <<= 1) v = fmaxf(v, __shfl_xor(v, o));
    return v;
}
__device__ __forceinline__ float silu_f(float x) { return x / (1.f + __expf(-x)); }
__device__ __forceinline__ int t5_bucket(int dist) {
    const int n = dist > 0 ? dist : 0;
    if (n < 16) return n;
    const int large = 16 + (int)(logf((float)n / 16.f) / 2.0794415416798357f * 16.f);
    return large < 31 ? large : 31;
}
#define XB_TMO      128
#define XB_XCNT(j)  (256  + 64 * (j))
#define XB_XSUB(j)  (1280 + 64 * (j))
#define XB_XGEN(j)  (2304 + 64 * (j))
#define XB_TOP      3328
#define XB_TOPGEN   3392
#define XCD_BAR_WORDS 3456
#define XB_SPIN_CAP (1u << 18)

__device__ __forceinline__ unsigned xb_ld(unsigned* p)              { return __hip_atomic_load(p, __ATOMIC_RELAXED, __HIP_MEMORY_SCOPE_AGENT); }
__device__ __forceinline__ unsigned xb_add(unsigned* p, unsigned v) { return __hip_atomic_fetch_add(p, v, __ATOMIC_RELAXED, __HIP_MEMORY_SCOPE_AGENT); }
__device__ __forceinline__ unsigned xb_xcc_id() { return (unsigned)__builtin_amdgcn_s_getreg((3 << 11) | 20) & 0xFu; }
#define XB_SPIN(cond, bar) do { unsigned _sp = 0; while (cond) { __builtin_amdgcn_s_sleep(1); \
    if ((++_sp & 255u) == 0u) { if (xb_ld(&(bar)[XB_TMO])) break; if (_sp > XB_SPIN_CAP) { atomicAdd(&(bar)[XB_TMO], 1u); break; } } } } while (0)

struct XcdBarrier {
    unsigned* bar; unsigned x;
    volatile LAS unsigned* st;
};

__device__ __forceinline__ XcdBarrier xcd_barrier_post(unsigned* bar, volatile LAS unsigned* st) {
    XcdBarrier b; b.bar = bar; b.x = xb_xcc_id(); b.st = st;
    if (threadIdx.x == 0) (void)xb_add(&bar[XB_XCNT(b.x)], 1u);
    return b;
}
__device__ __forceinline__ void xcd_barrier_complete(unsigned* bar, unsigned x, unsigned& nloc, unsigned& nx) {
    const unsigned G = gridDim.x * gridDim.y * gridDim.z;
    unsigned sum, cnt, mine, sp = 0u;
    for (;;) {
        sum = 0u; cnt = 0u; mine = 0u;
#pragma unroll
        for (unsigned j = 0; j < 16; ++j) { const unsigned c = xb_ld(&bar[XB_XCNT(j)]); sum += c; cnt += (c > 0u) ? 1u : 0u; mine = (j == x) ? c : mine; }
        if (sum == G) break;
        __builtin_amdgcn_s_sleep(1);
        if ((++sp & 255u) == 0u) { if (xb_ld(&bar[XB_TMO])) break; if (sp > XB_SPIN_CAP) { atomicAdd(&bar[XB_TMO], 1u); break; } }
    }
    nloc = mine > 0u ? mine : 1u; nx = cnt > 0u ? cnt : 1u;
}

__device__ __forceinline__ void xcd_barrier(const XcdBarrier& b) {
    asm volatile("s_waitcnt vmcnt(0)" ::: "memory");
    __syncthreads();
    if (threadIdx.x == 0) {
        unsigned* bar = b.bar;
        __builtin_amdgcn_s_waitcnt(0);
        unsigned nloc = b.st[0], nx = b.st[1];
        if (nloc == 0u) { xcd_barrier_complete(bar, b.x, nloc, nx); b.st[0] = nloc; b.st[1] = nx; }
        const unsigned old = xb_add(&bar[XB_XSUB(b.x)], 1u);
        const unsigned gen = old / nloc;
        if (old + 1u == (gen + 1u) * nloc) {
            __builtin_amdgcn_fence(__ATOMIC_RELEASE, "agent");
            asm volatile("s_waitcnt vmcnt(0)" ::: "memory");
            const unsigned og = xb_add(&bar[XB_TOP], 1u);
            const unsigned tg = og / nx;
            if (og + 1u == (tg + 1u) * nx) xb_add(&bar[XB_TOPGEN], 1u);
            else XB_SPIN(xb_ld(&bar[XB_TOPGEN]) == tg, bar);
            __builtin_amdgcn_fence(__ATOMIC_ACQUIRE, "agent");
            xb_add(&bar[XB_XGEN(b.x)], 1u);
            asm volatile("s_waitcnt vmcnt(0)" ::: "memory");
        } else {
            XB_SPIN(xb_ld(&bar[XB_XGEN(b.x)]) == gen, bar);
            __builtin_amdgcn_fence(__ATOMIC_ACQUIRE, "agent");
            asm volatile("s_waitcnt vmcnt(0)" ::: "memory");
        }
    }
    __syncthreads();
}

struct Frame {
    LAS unsigned char* lds;
    unsigned char* ldsg;
    volatile LAS unsigned* MISC;
    int tid, lane, wave, vcu, G;
    const float *x, *norm_gain, *final_gain, *rel_bias, *w_in_even, *gla_w_up, *gla_b_up, *gla_gain, *sinks, *w_out_even, *w_in_odd, *w_out_odd;
    float* out;
    unsigned char* ws;
    bf16 *WT0, *WTO0, *WT1, *WTO1, *XN, *MIX, *PROJ, *ST;
    float *LOGA, *KMEAN, *DEC, *KVC, *GO;
};

__device__ __forceinline__ void p0_transpose_item(const float* W, int ldw, int K, bf16* WT, int k0, int n_src0, int n_dst0, LAS float* scr, int lane) {
#pragma unroll 8
    for (int i = 0; i < 32; ++i) { const int kk = 2 * i + (lane >> 5); scr[kk * 33 + (lane & 31)] = W[(size_t)(k0 + kk) * ldw + n_src0 + (lane & 31)]; }
    LDS_WAIT(); asm volatile("" ::: "memory");
    const int c = lane & 7;
#pragma unroll
    for (int j = 0; j < 4; ++j) { const int n = (lane >> 3) + 8 * j; const LAS float* s = scr + (8 * c) * 33 + n;
        v4u o; o.x = pk2(s[0 * 33], s[1 * 33]); o.y = pk2(s[2 * 33], s[3 * 33]); o.z = pk2(s[4 * 33], s[5 * 33]); o.w = pk2(s[6 * 33], s[7 * 33]);
        *(GAS v4u*)(WT + (size_t)(n_dst0 + n) * K + k0 + 8 * c) = o; }
    LDS_WAIT(); asm volatile("" ::: "memory");
}
__device__ __forceinline__ void rms_row_to_bf16(const float* xrow, const float* g, bf16* orow, int lane) {
    const GAS f32x4* xr = (const GAS f32x4*)xrow + lane;
    const GAS f32x4* gr = (const GAS f32x4*)g + lane;
    f32x4 v[4]; float s = 0.f;
#pragma unroll
    for (int j = 0; j < 4; ++j) { v[j] = xr[64 * j]; s += (v[j].x * v[j].x + v[j].y * v[j].y) + (v[j].z * v[j].z + v[j].w * v[j].w); }
    const float rs = 1.0f / sqrtf(wave_sum(s) * (1.f / DM) + EPS);
    GAS unsigned long long* o8 = (GAS unsigned long long*)orow + lane;
#pragma unroll
    for (int j = 0; j < 4; ++j) { const f32x4 gg = gr[64 * j];
        o8[64 * j] = (unsigned long long)pk2(v[j].x * rs * gg.x, v[j].y * rs * gg.y) | ((unsigned long long)pk2(v[j].z * rs * gg.z, v[j].w * rs * gg.w) << 32); }
}
__device__ __forceinline__ void p0_prologue(Frame& F) {
    LAS float* scr = (LAS float*)(F.lds + F.wave * 16384);
    const int gw = F.vcu * NWAVES + F.wave, NGW = F.G * NWAVES;
    constexpr int KB = DM / 64;
    constexpr int I_0 = KB * (N0 / 32), I_O = KB * (DM / 32), I_1 = KB * (N1 / 32);
    constexpr int NITEMS = I_0 + I_O + I_1 + I_O;
    for (int it = gw; it < NITEMS; it += NGW) {
        int r = it;
        if (r < I_0) { const int kb = r / (N0 / 32), nb = r % (N0 / 32), nd = nb * 32, ns = nd + (nd >= 1024 ? 16 : 0);
            p0_transpose_item(F.w_in_even, EC_SRC, DM, F.WT0, kb * 64, ns, nd, scr, F.lane); continue; } r -= I_0;
        if (r < I_O) { const int kb = r / (DM / 32), nb = r % (DM / 32); p0_transpose_item(F.w_out_even, DM, DM, F.WTO0, kb * 64, nb * 32, nb * 32, scr, F.lane); continue; } r -= I_O;
        if (r < I_1) { const int kb = r / (N1 / 32), nb = r % (N1 / 32); p0_transpose_item(F.w_in_odd, OC_SRC, DM, F.WT1, kb * 64, nb * 32, nb * 32, scr, F.lane); continue; } r -= I_1;
        { const int kb = r / (DM / 32), nb = r % (DM / 32); p0_transpose_item(F.w_out_odd, DM, DM, F.WTO1, kb * 64, nb * 32, nb * 32, scr, F.lane); }
    }
    __syncthreads();
    LAS float* WdT = (LAS float*)(F.lds);
    LAS float* Wup = (LAS float*)(F.lds + 65536);
    LAS float* Bup = (LAS float*)(F.lds + 65536 + 16384);
    for (int i = F.tid; i < 16 * 1024; i += NTHR) { const int k = i >> 4, r = i & 15; WdT[r * 1024 + k] = F.w_in_even[(size_t)k * EC_SRC + 1024 + r]; }
    for (int i = F.tid; i < 16 * 256; i += NTHR) Wup[i] = F.gla_w_up[i];
    for (int i = F.tid; i < 256; i += NTHR) Bup[i] = F.gla_b_up[i];
    __syncthreads();
    const int lane = F.lane;
    for (int m = gw; m < M; m += NGW) {
        const GAS f32x4* xr = (const GAS f32x4*)(F.x + (size_t)m * DM) + lane;
        const GAS f32x4* gr = (const GAS f32x4*)F.norm_gain + lane;
        f32x4 v[4]; float s = 0.f;
#pragma unroll
        for (int j = 0; j < 4; ++j) { v[j] = xr[64 * j]; s += (v[j].x * v[j].x + v[j].y * v[j].y) + (v[j].z * v[j].z + v[j].w * v[j].w); }
        const float rs = 1.0f / sqrtf(wave_sum(s) * (1.f / DM) + EPS);
        GAS unsigned long long* o8 = (GAS unsigned long long*)(F.XN + (size_t)m * DM) + lane;
#pragma unroll
        for (int j = 0; j < 4; ++j) { const f32x4 gg = gr[64 * j]; v[j].x *= rs * gg.x; v[j].y *= rs * gg.y; v[j].z *= rs * gg.z; v[j].w *= rs * gg.w;
            o8[64 * j] = (unsigned long long)pk2(v[j].x, v[j].y) | ((unsigned long long)pk2(v[j].z, v[j].w) << 32); }
        f32x4 z = *(const LAS f32x4*)(Bup + 4 * lane);
#pragma unroll 2
        for (int r = 0; r < 16; ++r) { float a = 0.f;
#pragma unroll
            for (int j = 0; j < 4; ++j) { const f32x4 w = *(const LAS f32x4*)(WdT + r * 1024 + 256 * j + 4 * lane); a += (v[j].x * w.x + v[j].y * w.y) + (v[j].z * w.z + v[j].w * w.w); }
            const float ad = wave_sum(a);
            const f32x4 wu = *(const LAS f32x4*)(Wup + r * 256 + 4 * lane); z += ad * wu; }
        f32x4 la;
#pragma unroll
        for (int i = 0; i < 4; ++i) la[i] = (fminf(z[i], 0.f) - log1pf(__expf(-fabsf(z[i])))) * (1.0f / 16.0f);
        *((GAS f32x4*)(F.LOGA + (size_t)m * 256) + lane) = la;
    }
}

__device__ __forceinline__ void p2_gla_naive(Frame& F) {
    for (int u = blockIdx.x; u < 256; u += F.G) {
        const int bh = u >> 5, b = bh >> 2, h = bh & 3, e = (u & 31) * 4 + F.wave, d = F.lane;
        if (F.wave < 4) {
            float st = 0.f;
#pragma unroll 8
            for (int t = 0; t < SEQ; ++t) {
                const size_t row = (size_t)b * SEQ + t;
                const bf16* pr = F.PROJ + row * N0;
                const float q = bf2f(pr[P0_AQ + h * 64 + d]), k = bf2f(pr[P0_AK + h * 64 + d]), v = bf2f(pr[P0_AV + h * 128 + e]);
                const float alpha = __expf(F.LOGA[row * 256 + h * 64 + d]);
                st = alpha * st + k * v;
                const float o = wave_sum(q * st);
                if (d == 0) F.GO[row * 512 + h * 128 + e] = o;
            }
        }
    }
}
__device__ __forceinline__ void p4_gla_post_naive(Frame& F) {
    const int gw = F.vcu * NWAVES + F.wave, NGW = F.G * NWAVES, lane = F.lane;
    for (int it = gw; it < M * 4; it += NGW) {
        const int row = it >> 2, h = it & 3;
        const float* o = F.GO + (size_t)row * 512 + h * 128;
        const float a = o[lane], c = o[lane + 64];
        const float rs = 1.0f / sqrtf(wave_sum(a * a + c * c) * (1.0f / 128.f) + EPS);
        const bf16* g = F.PROJ + (size_t)row * N0 + P0_AG + h * 128;
        bf16* mo = F.MIX + (size_t)row * DM + h * 128;
        mo[lane] = (bf16)f2bf(a * rs * F.gla_gain[lane] * silu_f(bf2f(g[lane])));
        mo[lane + 64] = (bf16)f2bf(c * rs * F.gla_gain[lane + 64] * silu_f(bf2f(g[lane + 64])));
    }
}
__device__ __forceinline__ void p3_swa_naive(Frame& F) {
    for (int gid = blockIdx.x * NTHR + F.tid; gid < M * 8; gid += F.G * NTHR) {
        const int h = gid & 7, row = gid >> 3, b = row / SEQ, t = row % SEQ, kvh = h >> 2;
        const bf16* pr = F.PROJ + (size_t)row * N0;
        float q[64];
#pragma unroll
        for (int i = 0; i < 64; ++i) q[i] = bf2f(pr[P0_BQ + h * 64 + i]);
        float m = F.sinks[h] * LOG2E, l = 1.f, o[64];
#pragma unroll
        for (int i = 0; i < 64; ++i) o[i] = 0.f;
        const int j0 = t - 127 > 0 ? t - 127 : 0;
        for (int j = j0; j <= t; ++j) {
            const bf16* kr = F.PROJ + (size_t)(b * SEQ + j) * N0 + P0_BK + kvh * 64;
            const bf16* vr = F.PROJ + (size_t)(b * SEQ + j) * N0 + P0_BV + kvh * 64;
            float s = 0.f;
#pragma unroll
            for (int i = 0; i < 64; ++i) s += q[i] * bf2f(kr[i]);
            s += F.rel_bias[t5_bucket(t - j) * 8 + h] * LOG2E;
            const float mn = fmaxf(m, s), f = exp2f(m - mn), p = exp2f(s - mn);
            l = l * f + p; m = mn;
#pragma unroll
            for (int i = 0; i < 64; ++i) o[i] = o[i] * f + p * bf2f(vr[i]);
        }
        const float inv = 1.f / l;
#pragma unroll
        for (int i = 0; i < 64; ++i) F.MIX[(size_t)row * DM + 512 + h * 64 + i] = (bf16)f2bf(o[i] * inv * silu_f(bf2f(pr[P0_BG + h * 64 + i])));
    }
}
__device__ __forceinline__ void p8_kmean_naive(Frame& F) {
    for (int gid = blockIdx.x * NTHR + F.tid; gid < 128 * 128; gid += F.G * NTHR) {
        const int item = gid >> 7, d = gid & 127, n = item & 31, bk = item >> 5, b = bk >> 1, kvh = bk & 1;
        float s = 0.f;
        for (int r = 0; r < 256; ++r) s += bf2f(F.PROJ[(size_t)(b * SEQ + n * 256 + r) * N1 + P1_CK + kvh * 128 + d]);
        F.KMEAN[(size_t)item * 128 + d] = s * (1.0f / 256.f);
    }
}
__device__ __forceinline__ void p9_moba_naive(Frame& F) {
    LAS float* qs = (LAS float*)(F.lds) + F.wave * 128;
    const int gw = F.vcu * NWAVES + F.wave, NGW = F.G * NWAVES, lane = F.lane;
    for (int item = gw; item < M * 8; item += NGW) {
        const int h = item & 7, row = item >> 3, b = row / SEQ, t = row % SEQ, kvh = h >> 2, own = t >> 8;
        const bf16* pr = F.PROJ + (size_t)row * N1;
        LDS_WAIT();
        qs[lane] = bf2f(pr[P1_CQ + h * 128 + lane]); qs[lane + 64] = bf2f(pr[P1_CQ + h * 128 + lane + 64]);
        LDS_WAIT(); asm volatile("" ::: "memory");
        const LAS f32x4* q4 = (const LAS f32x4*)qs;
        float gate = -INFINITY;
        if (lane < own) { const GAS f32x4* km = (const GAS f32x4*)(F.KMEAN + ((size_t)((b * 2 + kvh) * 32 + lane)) * 128); float s = 0.f;
            for (int i = 0; i < 32; ++i) { const f32x4 a = q4[i], c = km[i]; s += (a.x * c.x + a.y * c.y) + (a.z * c.z + a.w * c.w); } gate = s; }
        int s0 = -1, s1 = -1, s2 = -1;
#pragma unroll
        for (int r = 0; r < 3; ++r) {
            const float mx = wave_max(gate);
            int idx = -1;
            if (mx != -INFINITY) { const unsigned long long bal = __ballot(gate == mx); idx = __ffsll((long long)bal) - 1; if (lane == idx) gate = -INFINITY; }
            if (r == 0) s0 = idx; else if (r == 1) s1 = idx; else s2 = idx;
        }
        float m = -INFINITY, l = 0.f, o0 = 0.f, o1 = 0.f;
        for (int si = 0; si < 4; ++si) {
            const int blk = si == 0 ? s0 : (si == 1 ? s1 : (si == 2 ? s2 : own));
            if (blk < 0) continue;
            for (int c = 0; c < 4; ++c) {
                const int kpos = blk * 256 + c * 64 + lane;
                float s = -INFINITY;
                if (kpos <= t) {
                    const GAS v4u* kr = (const GAS v4u*)(F.PROJ + (size_t)(b * SEQ + kpos) * N1 + P1_CK + kvh * 128);
                    float a = 0.f;
                    for (int i = 0; i < 16; ++i) { const v4u kk = kr[i]; const f32x4 qa = q4[2 * i], qb = q4[2 * i + 1];
                        a += (qa.x * bflo(kk.x) + qa.y * bfhi(kk.x)) + (qa.z * bflo(kk.y) + qa.w * bfhi(kk.y)) + (qb.x * bflo(kk.z) + qb.y * bfhi(kk.z)) + (qb.z * bflo(kk.w) + qb.w * bfhi(kk.w)); }
                    s = a + F.rel_bias[t5_bucket(t - kpos) * 8 + h] * LOG2E;
                }
                const float cm = wave_max(s);
                if (cm == -INFINITY) continue;
                const float mn = fmaxf(m, cm), f = exp2f(m - mn), p = exp2f(s - mn);
                l = l * f + wave_sum(p); m = mn; o0 *= f; o1 *= f;
                for (int j = 0; j < 64; ++j) {
                    const float pj = __shfl(p, j);
                    const unsigned vv = *(const GAS unsigned*)(F.PROJ + (size_t)(b * SEQ + blk * 256 + c * 64 + j) * N1 + P1_CV + kvh * 128 + 2 * lane);
                    o0 += pj * bflo(vv); o1 += pj * bfhi(vv);
                }
            }
        }
        const float inv = 1.f / l;
        const unsigned gg = *(const GAS unsigned*)(pr + P1_CG + h * 128 + 2 * lane);
        *(GAS unsigned*)(F.MIX + (size_t)row * DM + h * 128 + 2 * lane) = pk2(o0 * inv * silu_f(bflo(gg)), o1 * inv * silu_f(bfhi(gg)));
    }
}
__device__ __forceinline__ void p_rms_rows_bf16(Frame& F, const float* src, const float* g, bf16* dst) {
    const int gw = F.vcu * NWAVES + F.wave, NGW = F.G * NWAVES;
    for (int m = gw; m < M; m += NGW) rms_row_to_bf16(src + (size_t)m * DM, g, dst + (size_t)m * DM, F.lane);
}
__device__ __forceinline__ void p_rms_rows_f32_inplace(Frame& F, float* buf, const float* g) {
    const int gw = F.vcu * NWAVES + F.wave, NGW = F.G * NWAVES, lane = F.lane;
    for (int m = gw; m < M; m += NGW) {
        GAS f32x4* xr = (GAS f32x4*)(buf + (size_t)m * DM) + lane;
        const GAS f32x4* gr = (const GAS f32x4*)g + lane;
        f32x4 v[4]; float s = 0.f;
#pragma unroll
        for (int j = 0; j < 4; ++j) { v[j] = xr[64 * j]; s += (v[j].x * v[j].x + v[j].y * v[j].y) + (v[j].z * v[j].z + v[j].w * v[j].w); }
        const float rs = 1.0f / sqrtf(wave_sum(s) * (1.f / DM) + EPS);
#pragma unroll
        for (int j = 0; j < 4; ++j) { const f32x4 gg = gr[64 * j]; f32x4 o; o.x = v[j].x * rs * gg.x; o.y = v[j].y * rs * gg.y; o.z = v[j].z * rs * gg.z; o.w = v[j].w * rs * gg.w; xr[64 * j] = o; }
    }
}

typedef float f32x2_t __attribute__((ext_vector_type(2)));
typedef __bf16 bf16x2_t __attribute__((ext_vector_type(2)));
typedef short v4i16_t __attribute__((ext_vector_type(4)));
__device__ __forceinline__ unsigned cvtpk(float lo, float hi) { f32x2_t v = {lo, hi}; bf16x2_t b = __builtin_convertvector(v, bf16x2_t); return __builtin_bit_cast(unsigned, b); }
__device__ __forceinline__ int crow(int r, int hi) { return (r & 3) + 8 * (r >> 2) + 4 * hi; }
#define MFMA32(a, b, c) __builtin_amdgcn_mfma_f32_32x32x16_bf16((a), (b), (c), 0, 0, 0)
__device__ __forceinline__ bf16x8 pack8(const f32x16& x, int s) {
    v4u p; p.x = cvtpk(x[8 * s + 0], x[8 * s + 1]); p.y = cvtpk(x[8 * s + 2], x[8 * s + 3]); p.z = cvtpk(x[8 * s + 4], x[8 * s + 5]); p.w = cvtpk(x[8 * s + 6], x[8 * s + 7]);
    return __builtin_bit_cast(bf16x8, p);
}
__device__ __forceinline__ v4i16_t tr_read(LAS unsigned char* p) { return __builtin_amdgcn_ds_read_tr16_b64_v4i16((LAS v4i16_t*)p); }
__device__ __forceinline__ bf16x8 join4(v4i16_t lo, v4i16_t hi) { return (bf16x8){lo[0], lo[1], lo[2], lo[3], hi[0], hi[1], hi[2], hi[3]}; }
__device__ __forceinline__ float ex2(float x) { return __builtin_amdgcn_exp2f(x); }

constexpr int SWA_K = 0, SWA_V = 32768, SWA_BIAS = 65536, SWA_WSF = 67584, SWA_STG = 68608, SWA_STG_W = 4608;
__device__ __forceinline__ int swa_offK(int r, int ch) { return 128 * r + 16 * (ch ^ ((r >> 1) & 7)); }
__device__ __forceinline__ int swa_offV(int r, int ch) { return 128 * r + 16 * (ch ^ (((r >> 1) & 1) << 2)); }
__device__ __forceinline__ void p_swa(Frame& F) {
    const int tid = F.tid, lane = F.lane, wave = F.wave, c = lane & 31, hi = lane >> 5;
    const int tq = (lane & 15) >> 2, tp = lane & 3, tblk = (lane >> 4) & 1;
    LAS float* biasL = (LAS float*)(F.lds + SWA_BIAS);
    LAS float* wsf = (LAS float*)(F.lds + SWA_WSF) + wave * 32;
    LAS float* stg = (LAS float*)(F.lds + SWA_STG + wave * SWA_STG_W);
    for (int u = blockIdx.x; u < 256; u += F.G) {
        const int nb = u & 63, bk = u >> 6, b = bk >> 1, kvh = bk & 1;
        __syncthreads();
#pragma unroll
        for (int i = 0; i < 4; ++i) {
            const int idx = tid + NTHR * i, r = idx >> 3, ch = idx & 7, kpos = (nb - 1) * 128 + r;
            v4u kk = {0u, 0u, 0u, 0u}, vv = {0u, 0u, 0u, 0u};
            if (kpos >= 0) { const bf16* src = F.PROJ + (size_t)(b * SEQ + kpos) * N0 + kvh * 64 + ch * 8; kk = *(const GAS v4u*)(src + P0_BK); vv = *(const GAS v4u*)(src + P0_BV); }
            *(LAS v4u*)(F.lds + SWA_K + swa_offK(r, ch)) = kk;
            *(LAS v4u*)(F.lds + SWA_V + swa_offV(r, ch)) = vv;
        }
        { const int g = tid >> 7, dist = tid & 127; biasL[tid] = F.rel_bias[t5_bucket(dist) * 8 + kvh * 4 + g] * LOG2E; }
        __syncthreads();
        const int g = wave >> 1, head = kvh * 4 + g, qh = wave & 1;
        const float sink2 = F.sinks[head] * LOG2E;
#pragma unroll 1
        for (int i = 0; i < 2; ++i) {
            const int q0 = 64 * qh + 32 * i, kt0 = q0 >> 5;
            const size_t rowbase = (size_t)b * SEQ + nb * 128 + q0;
            bf16x8 qf[4];
            { const bf16* qp = F.PROJ + (rowbase + c) * N0 + P0_BQ + head * 64 + 8 * hi;
#pragma unroll
              for (int ks = 0; ks < 4; ++ks) qf[ks] = *(const GAS bf16x8*)(qp + 16 * ks); }
            f32x16 st[5];
#pragma unroll
            for (int kk = 0; kk < 5; ++kk) {
                f32x16 acc = {};
                const int kr = 32 * (kt0 + kk) + c;
#pragma unroll
                for (int ks = 0; ks < 4; ++ks) { const bf16x8 kf = *(const LAS bf16x8*)(F.lds + SWA_K + swa_offK(kr, 2 * ks + hi)); acc = MFMA32(kf, qf[ks], acc); }
                st[kk] = acc;
            }
            float m = sink2;
#pragma unroll
            for (int kk = 0; kk < 5; ++kk)
#pragma unroll
                for (int r = 0; r < 16; ++r) {
                    const int keyl = crow(r, hi), dist = 128 + c - 32 * kk - keyl;
                    bool ok = true;
                    if (kk == 0) ok = dist < 128;
                    if (kk == 4) ok = dist >= 0;
                    ok = ok && (nb > 0 || 32 * (kt0 + kk) + keyl >= 128);
                    const float s = ok ? st[kk][r] + biasL[g * 128 + (dist & 127)] : -INFINITY;
                    st[kk][r] = s; m = fmaxf(m, s);
                }
            m = fmaxf(m, __shfl_xor(m, 32));
            float l = 0.f;
#pragma unroll
            for (int kk = 0; kk < 5; ++kk)
#pragma unroll
                for (int r = 0; r < 16; ++r) { const float p = ex2(st[kk][r] - m); st[kk][r] = p; l += p; }
            l += __shfl_xor(l, 32);
            l += ex2(sink2 - m);
            f32x16 o[2]; o[0] = (f32x16){}; o[1] = (f32x16){};
#pragma unroll
            for (int kk = 0; kk < 5; ++kk)
#pragma unroll
                for (int s2 = 0; s2 < 2; ++s2) {
                    const bf16x8 pf = pack8(st[kk], s2);
                    const int vr = 32 * (kt0 + kk) + 16 * s2 + 4 * hi + tq;
#pragma unroll
                    for (int dt = 0; dt < 2; ++dt) {
                        const int ch = 4 * dt + 2 * tblk + (tp >> 1);
                        const v4i16_t lo = tr_read(F.lds + SWA_V + swa_offV(vr, ch) + 8 * (tp & 1));
                        const v4i16_t hh = tr_read(F.lds + SWA_V + swa_offV(vr + 8, ch) + 8 * (tp & 1));
                        o[dt] = MFMA32(pf, join4(lo, hh), o[dt]);
                    }
                }
            if (hi == 0) wsf[c] = 1.0f / l;
            LDS_WAIT(); asm volatile("" ::: "memory");
#pragma unroll
            for (int r = 0; r < 16; ++r) { const float inv = wsf[crow(r, hi)]; o[0][r] *= inv; o[1][r] *= inv; }
#pragma unroll
            for (int dt = 0; dt < 2; ++dt) {
#pragma unroll
                for (int r = 0; r < 16; ++r) stg[crow(r, hi) * 36 + c] = o[dt][r];
                LDS_WAIT(); asm volatile("" ::: "memory");
#pragma unroll
                for (int i4 = 0; i4 < 4; ++i4) {
                    const int rr = i4 * 8 + (lane >> 3), ch = lane & 7;
                    const f32x4 v = *(const LAS f32x4*)(stg + rr * 36 + ch * 4);
                    const size_t grow = rowbase + rr; const int col = head * 64 + 32 * dt + ch * 4;
                    const v2u gg = *(const GAS v2u*)(F.PROJ + grow * N0 + P0_BG + col);
                    v2u ov; ov.x = cvtpk(v.x * silu_f(bflo(gg.x)), v.y * silu_f(bfhi(gg.x))); ov.y = cvtpk(v.z * silu_f(bflo(gg.y)), v.w * silu_f(bfhi(gg.y)));
                    *(GAS v2u*)(F.MIX + grow * DM + 512 + col) = ov;
                }
                LDS_WAIT(); asm volatile("" ::: "memory");
            }
        }
    }
}
constexpr int GA_QE = 0, GA_KE = 9216, GA_KPT = 18432, GA_VT = 27648, GA_TOT = 46080;
__device__ __forceinline__ void p_gla_a(Frame& F) {
    const int tid = F.tid, lane = F.lane, wave = F.wave, c = lane & 31, hi = lane >> 5;
    const int d = tid & 63, part = wave;
    LAS float* TOT = (LAS float*)(F.lds + GA_TOT);
    for (int u = blockIdx.x; u < 1024; u += F.G) {
        const int n = u & 127, bh = u >> 7, b = bh >> 2, h = bh & 3;
        const size_t row0 = (size_t)b * SEQ + n * 64;
        __syncthreads();
        float la[8]; bf16 qv[8], kv[8];
#pragma unroll
        for (int i = 0; i < 8; ++i) { const size_t row = row0 + part * 8 + i; la[i] = F.LOGA[row * 256 + h * 64 + d]; const bf16* pr = F.PROJ + row * N0 + h * 64 + d; qv[i] = pr[P0_AQ]; kv[i] = pr[P0_AK]; }
#pragma unroll
        for (int j = 0; j < 2; ++j) {
            const int idx = tid + NTHR * j, cr = idx >> 4, ch = idx & 15;
            const v4u vv = *(const GAS v4u*)(F.PROJ + (row0 + cr) * N0 + P0_AV + h * 128 + ch * 8);
            LAS bf16* vt = (LAS bf16*)(F.lds + GA_VT) + (ch * 8) * 72 + cr;
            vt[0 * 72] = (bf16)(vv.x & 0xffffu); vt[1 * 72] = (bf16)(vv.x >> 16); vt[2 * 72] = (bf16)(vv.y & 0xffffu); vt[3 * 72] = (bf16)(vv.y >> 16);
            vt[4 * 72] = (bf16)(vv.z & 0xffffu); vt[5 * 72] = (bf16)(vv.z >> 16); vt[6 * 72] = (bf16)(vv.w & 0xffffu); vt[7 * 72] = (bf16)(vv.w >> 16);
        }
        { float p = 0.f;
#pragma unroll
          for (int i = 0; i < 8; ++i) { p += la[i]; la[i] = p; }
          TOT[part * 64 + d] = p; }
        __syncthreads();
        float off = 0.f, blast = 0.f;
#pragma unroll
        for (int pp = 0; pp < 8; ++pp) { const float t = TOT[pp * 64 + d]; blast += t; if (pp < part) off += t; }
        v4u kpw;
        {   unsigned kp[8];
#pragma unroll
            for (int i = 0; i < 8; ++i) {
                const float bc = off + la[i]; const int cc = part * 8 + i;
                const float qf = bf2f(qv[i]), kf = bf2f(kv[i]);
                ((LAS bf16*)(F.lds + GA_QE))[cc * 72 + d] = (bf16)f2bf(qf * __expf(bc));
                ((LAS bf16*)(F.lds + GA_KE))[cc * 72 + d] = (bf16)f2bf(kf * __expf(-bc));
                kp[i] = f2bf(kf * __expf(blast - bc));
            }
            kpw.x = kp[0] | (kp[1] << 16); kpw.y = kp[2] | (kp[3] << 16); kpw.z = kp[4] | (kp[5] << 16); kpw.w = kp[6] | (kp[7] << 16);
        }
        *(LAS v4u*)(F.lds + GA_KPT + d * 144 + part * 16) = kpw;
        if (part == 0) F.DEC[u * 64 + d] = __expf(blast);
        __syncthreads();
        const int et = wave >> 1, ct = wave & 1;
        f32x16 oacc = {};
#pragma unroll
        for (int st = 0; st < 2; ++st) {
            if (st <= ct) {
                f32x16 x = {};
#pragma unroll
                for (int ks = 0; ks < 4; ++ks) {
                    const bf16x8 A = *(const LAS bf16x8*)(F.lds + GA_KE + (32 * st + c) * 144 + 32 * ks + 16 * hi);
                    const bf16x8 B = *(const LAS bf16x8*)(F.lds + GA_QE + (32 * ct + c) * 144 + 32 * ks + 16 * hi);
                    x = MFMA32(A, B, x);
                }
                if (st == ct) {
#pragma unroll
                    for (int r = 0; r < 16; ++r) if (crow(r, hi) > c) x[r] = 0.f;
                }
#pragma unroll
                for (int s2 = 0; s2 < 2; ++s2) {
                    const bf16x8 xs = pack8(x, s2);
                    const int addr = GA_VT + (32 * et + c) * 144 + 64 * st + 32 * s2 + 8 * hi;
                    const v2u lo = *(const LAS v2u*)(F.lds + addr), hh = *(const LAS v2u*)(F.lds + addr + 16);
                    v4u pa; pa.x = lo.x; pa.y = lo.y; pa.z = hh.x; pa.w = hh.y;
                    oacc = MFMA32(__builtin_bit_cast(bf16x8, pa), xs, oacc);
                }
            }
        }
        { float* oi = F.GO + ((size_t)u * 8 + wave) * 1024 + lane * 4;
#pragma unroll
          for (int i4 = 0; i4 < 4; ++i4) { f32x4 v; v.x = oacc[4 * i4]; v.y = oacc[4 * i4 + 1]; v.z = oacc[4 * i4 + 2]; v.w = oacc[4 * i4 + 3]; *(GAS f32x4*)(oi + i4 * 256) = v; } }
        f32x16 kvacc = {};
#pragma unroll
        for (int ks = 0; ks < 4; ++ks) {
            const bf16x8 A = *(const LAS bf16x8*)(F.lds + GA_VT + (32 * et + c) * 144 + 32 * ks + 16 * hi);
            const bf16x8 B = *(const LAS bf16x8*)(F.lds + GA_KPT + (32 * ct + c) * 144 + 32 * ks + 16 * hi);
            kvacc = MFMA32(A, B, kvacc);
        }
        { float* kc = F.KVC + (size_t)u * 8192 + (32 * et) * 64 + 32 * ct + c;
#pragma unroll
          for (int r = 0; r < 16; ++r) kc[crow(r, hi) * 64] = kvacc[r]; }
        { const int cr = tid >> 3, ch = tid & 7; const v4u v = *(const LAS v4u*)(F.lds + GA_QE + cr * 144 + ch * 16);
          *(GAS v4u*)(F.PROJ + (row0 + cr) * N0 + P0_AQ + h * 64 + ch * 8) = v; }
    }
}
__device__ __forceinline__ void p_gla_scan(Frame& F) {
    if (F.tid < 256) {
        for (int idx = blockIdx.x * 256 + F.tid; idx < 65536; idx += F.G * 256) {
            const int bh = idx >> 13, ed = idx & 8191, dd = ed & 63;
            const float* kv = F.KVC + (size_t)bh * 128 * 8192 + ed; const float* dc = F.DEC + bh * 128 * 64 + dd; bf16* st = F.ST + (size_t)bh * 128 * 8192 + ed;
            float s = 0.f;
            for (int n0 = 0; n0 < 128; n0 += 16) {
                float kvv[16], dv[16];
#pragma unroll
                for (int j = 0; j < 16; ++j) { kvv[j] = kv[(size_t)(n0 + j) * 8192]; dv[j] = dc[(n0 + j) * 64]; }
#pragma unroll
                for (int j = 0; j < 16; ++j) { st[(size_t)(n0 + j) * 8192] = (bf16)f2bf(s); s = dv[j] * s + kvv[j]; }
            }
        }
    }
}
__device__ __forceinline__ void p_gla_b(Frame& F) {
    const int lane = F.lane, wave = F.wave, c = lane & 31, hi = lane >> 5;
    LAS float* stg = (LAS float*)(F.lds + wave * 8704);
    for (int ug = blockIdx.x; ug < 256; ug += F.G) {
        const int u = ug * 4 + (wave >> 1), ct = wave & 1;
        const int n = u & 127, bh = u >> 7, b = bh >> 2, h = bh & 3;
        const size_t row0 = (size_t)b * SEQ + n * 64;
        f32x16 acc[4];
        { const float* oi = F.GO + ((size_t)u * 8 + ct) * 1024 + lane * 4;
#pragma unroll
          for (int et = 0; et < 4; ++et)
#pragma unroll
              for (int i4 = 0; i4 < 4; ++i4) { const f32x4 v = *(const GAS f32x4*)(oi + et * 2048 + i4 * 256); acc[et][4 * i4] = v.x; acc[et][4 * i4 + 1] = v.y; acc[et][4 * i4 + 2] = v.z; acc[et][4 * i4 + 3] = v.w; } }
        bf16x8 qf[4];
        { const bf16* qp = F.PROJ + (row0 + 32 * ct + c) * N0 + P0_AQ + h * 64 + 8 * hi;
#pragma unroll
          for (int ks = 0; ks < 4; ++ks) qf[ks] = *(const GAS bf16x8*)(qp + 16 * ks); }
        { const bf16* sp = F.ST + (size_t)u * 8192 + c * 64 + 8 * hi;
#pragma unroll
          for (int et = 0; et < 4; ++et)
#pragma unroll
              for (int ks = 0; ks < 4; ++ks) { const bf16x8 A = *(const GAS bf16x8*)(sp + (32 * et) * 64 + 16 * ks); acc[et] = MFMA32(A, qf[ks], acc[et]); } }
        float ss = 0.f;
#pragma unroll
        for (int et = 0; et < 4; ++et)
#pragma unroll
            for (int r = 0; r < 16; ++r) ss += acc[et][r] * acc[et][r];
        ss += __shfl_xor(ss, 32);
        const float rs = 1.0f / sqrtf(ss * (1.0f / 128.f) + EPS);
#pragma unroll
        for (int half = 0; half < 2; ++half) {
#pragma unroll
            for (int et2 = 0; et2 < 2; ++et2)
#pragma unroll
                for (int g4 = 0; g4 < 4; ++g4) { const int et = half * 2 + et2; f32x4 v; v.x = acc[et][4 * g4] * rs; v.y = acc[et][4 * g4 + 1] * rs; v.z = acc[et][4 * g4 + 2] * rs; v.w = acc[et][4 * g4 + 3] * rs;
                    *(LAS f32x4*)(stg + c * 68 + et2 * 32 + 8 * g4 + 4 * hi) = v; }
            LDS_WAIT(); asm volatile("" ::: "memory");
#pragma unroll
            for (int i = 0; i < 8; ++i) {
                const int rr = i * 4 + (lane >> 4), ch = lane & 15, e = half * 64 + ch * 4;
                const f32x4 v = *(const LAS f32x4*)(stg + rr * 68 + ch * 4);
                const size_t grow = row0 + 32 * ct + rr;
                const v2u gg = *(const GAS v2u*)(F.PROJ + grow * N0 + P0_AG + h * 128 + e);
                const f32x4 gn = *(const GAS f32x4*)(F.gla_gain + e);
                v2u ov; ov.x = cvtpk(v.x * gn.x * silu_f(bflo(gg.x)), v.y * gn.y * silu_f(bfhi(gg.x))); ov.y = cvtpk(v.z * gn.z * silu_f(bflo(gg.y)), v.w * gn.w * silu_f(bfhi(gg.y)));
                *(GAS v2u*)(F.MIX + grow * DM + h * 128 + e) = ov;
            }
            LDS_WAIT(); asm volatile("" ::: "memory");
        }
    }
}
struct Args { const float* in[12]; float* out; unsigned char* ws; };
template <int LO, int HI>
__global__ void __launch_bounds__(NTHR, 2) fwd_kernel(Args args) {
    extern __shared__ __attribute__((aligned(16))) unsigned char lds[];
    Frame F;
    F.lds = (LAS unsigned char*)lds; F.ldsg = lds;
    F.MISC = (volatile LAS unsigned*)(F.lds + MISC_OFF);
    F.tid = threadIdx.x; F.lane = F.tid & 63; F.wave = __builtin_amdgcn_readfirstlane(F.tid >> 6);
    F.G = gridDim.x; { const int bx = blockIdx.x; F.vcu = (F.G % 8 == 0) ? (bx % 8) * (F.G / 8) + bx / 8 : bx; }
    F.x = args.in[0]; F.norm_gain = args.in[1]; F.final_gain = args.in[2]; F.rel_bias = args.in[3]; F.w_in_even = args.in[4]; F.gla_w_up = args.in[5];
    F.gla_b_up = args.in[6]; F.gla_gain = args.in[7]; F.sinks = args.in[8]; F.w_out_even = args.in[9]; F.w_in_odd = args.in[10]; F.w_out_odd = args.in[11];
    F.out = args.out; F.ws = args.ws;
    unsigned char* ws = args.ws;
    F.WT0 = (bf16*)(ws + WS_WT0); F.WTO0 = (bf16*)(ws + WS_WTO0); F.WT1 = (bf16*)(ws + WS_WT1); F.WTO1 = (bf16*)(ws + WS_WTO1);
    F.XN = (bf16*)(ws + WS_XN); F.MIX = (bf16*)(ws + WS_MIX); F.PROJ = (bf16*)(ws + WS_PROJ); F.ST = (bf16*)(ws + WS_ST);
    F.LOGA = (float*)(ws + WS_LOGA); F.KMEAN = (float*)(ws + WS_KMEAN); F.DEC = (float*)(ws + WS_DEC);
    F.KVC = (float*)((unsigned char*)args.out + DO_KVC); F.GO = (float*)((unsigned char*)args.out + DO_GO);
    for (int u = F.tid; u < (LDS_BYTES - LDSCTL_OFF) / 4; u += NTHR) ((LAS unsigned*)(F.lds + LDSCTL_OFF))[u] = 0u;
    __syncthreads();
    constexpr bool MULTI = (HI - LO) > 1;
    XcdBarrier bar; bar.bar = (unsigned*)(ws + WS_CTL) + CW_BAR; bar.x = 0; bar.st = nullptr;
    if (MULTI) bar = xcd_barrier_post((unsigned*)(ws + WS_CTL) + CW_BAR, F.MISC + 8);
#define IN(k) (LO <= (k) && (k) < HI)
#define SEAM(k) do { if (IN(k) && IN((k) + 1)) xcd_barrier(bar); } while (0)

    if constexpr (IN(0)) { p0_prologue(F); SEAM(0); }
    if constexpr (IN(1)) {
        pg8::Gemm g{F.XN, F.WT0, M, N0, DM}; pg8::StaticOrder S; S.init(M, N0, F.G, (int)blockIdx.x);
        pg8::EpiProj E{F.PROJ, N0, 0x001u, 0.125f, 0x0C0u, 0.125f * LOG2E};
        pg8::gemm_phase<pg8::EpiProj, pg8::StaticOrder, true, true>(F.lds, g, S, E);
        SEAM(1);
    }
    if constexpr (IN(2)) { p_gla_a(F); SEAM(2); }
    if constexpr (IN(3)) { p_gla_scan(F); p_swa(F); SEAM(3); }
    if constexpr (IN(4)) { p_gla_b(F); SEAM(4); }
    if constexpr (IN(5)) {
        pg8::Gemm g{F.MIX, F.WTO0, M, DM, DM}; pg8::StaticOrder S; S.init(M, DM, F.G, (int)blockIdx.x);
        pg8::EpiRes E{F.x, F.out, DM};
        pg8::gemm_phase<pg8::EpiRes, pg8::StaticOrder, false, true>(F.lds, g, S, E);
        SEAM(5);
    }
    if constexpr (IN(6)) { p_rms_rows_bf16(F, F.out, F.norm_gain + DM, F.XN); SEAM(6); }
    if constexpr (IN(7)) {
        pg8::Gemm g{F.XN, F.WT1, M, N1, DM}; pg8::StaticOrder S; S.init(M, N1, F.G, (int)blockIdx.x);
        pg8::EpiProj E{F.PROJ, N1, 0x00Fu, 0.08838834764831845f * LOG2E, 0u, 1.f};
        pg8::gemm_phase<pg8::EpiProj, pg8::StaticOrder, true, true>(F.lds, g, S, E);
        SEAM(7);
    }
    if constexpr (IN(8)) { p8_kmean_naive(F); SEAM(8); }
    if constexpr (IN(9)) { p9_moba_naive(F); SEAM(9); }
    if constexpr (IN(10)) {
        pg8::Gemm g{F.MIX, F.WTO1, M, DM, DM}; pg8::StaticOrder S; S.init(M, DM, F.G, (int)blockIdx.x);
        pg8::EpiRes E{F.out, F.out, DM};
        pg8::gemm_phase<pg8::EpiRes, pg8::StaticOrder, false, true>(F.lds, g, S, E);
        SEAM(10);
    }
    if constexpr (IN(11)) { p_rms_rows_f32_inplace(F, F.out, F.final_gain); }
#undef IN
#undef SEAM
}

template <int LO, int HI>
static void launch_range(const Args& a, int grid, hipStream_t stream) {
    static bool attr_done = false;
    if (!attr_done) { (void)hipFuncSetAttribute((const void*)fwd_kernel<LO, HI>, hipFuncAttributeMaxDynamicSharedMemorySize, LDS_BYTES); attr_done = true; }
    hipLaunchKernelGGL((fwd_kernel<LO, HI>), dim3(grid), dim3(NTHR), LDS_BYTES, stream, a);
}
#ifndef ONE_LAUNCH
#define ONE_LAUNCH 1
#endif
extern "C" void kernel_launch(void* const* d_in, const int* in_sizes, int n_in, void* d_out, int out_size, void* d_ws, size_t ws_size, hipStream_t stream) {
    static int grid = 0;
    if (grid == 0) {
        int dev = 0, cus = 0;
        if (hipGetDevice(&dev) != hipSuccess || hipDeviceGetAttribute(&cus, hipDeviceAttributeMultiprocessorCount, dev) != hipSuccess) { fprintf(stderr, "kernel_launch: device query failed\n"); grid = -1; return; }
        if (n_in != 12 || ws_size < WS_END) { fprintf(stderr, "kernel_launch: unexpected inputs / workspace\n"); grid = -1; return; }
        grid = cus;
    }
    if (grid < 0) return;
    (void)hipMemsetAsync((char*)d_ws + WS_CTL, 0, CTL_ZERO_BYTES, stream);
    Args a{};
    for (int i = 0; i < 12; ++i) a.in[i] = (const float*)d_in[i];
    a.out = (float*)d_out; a.ws = (unsigned char*)d_ws;
#if ONE_LAUNCH
    launch_range<0, NPHASE>(a, grid, stream);
#else
    launch_range<0, 1>(a, grid, stream); launch_range<1, 2>(a, grid, stream); launch_range<2, 3>(a, grid, stream); launch_range<3, 4>(a, grid, stream);
    launch_range<4, 5>(a, grid, stream); launch_range<5, 6>(a, grid, stream); launch_range<6, 7>(a, grid, stream); launch_range<7, 8>(a, grid, stream);
    launch_range<8, 9>(a, grid, stream); launch_range<9, 10>(a, grid, stream); launch_range<10, 11>(a, grid, stream); launch_range<11, 12>(a, grid, stream);
#endif
}
```

```cpp
#include <hip/hip_runtime.h>
#include <cstdio>
#include <cstdint>
#include <math.h>
namespace pg8 {
#define PG8_LAS __attribute__((address_space(3)))
typedef unsigned short bf16_t;
typedef short bf16x8 __attribute__((ext_vector_type(8)));
typedef float f32x4 __attribute__((ext_vector_type(4)));
typedef unsigned u32x4 __attribute__((ext_vector_type(4)));
constexpr int BM = 256, BK = 64, HALF = 128, HTB = HALF * BK * 2  , STAGE_BYTES = 8 * HTB, NXCD = 8, WGM = 8;

__host__ __device__ __forceinline__ int lds_byte(int r, int c) { const int st = (r >> 4) * 2 + (c >> 5), rr = r & 15, cc = c & 31, ob = rr * 64 + cc * 2; return st * 1024 + (ob ^ (((ob >> 9) & 1) << 5)); }
__host__ __device__ __forceinline__ void stage_rc(int b, int& R, int& C) { const int st = b / 1024, sb = b % 1024, swz = sb ^ (((sb >> 9) & 1) << 5); R = (st >> 1) * 16 + swz / 64; C = (st & 1) * 32 + (swz % 64) / 2; }
__host__ __device__ __forceinline__ int perm32(int rho) { const int n = rho >> 4, i = rho & 15; return 8 * (i >> 2) + 4 * n + (i & 3); }

struct Unit { int pm, pn; };
struct Gemm { const bf16_t* A; const bf16_t* Bt; int M, N, K; };

struct StaticOrder {
    int nM, nN, nwg, G, c;
    __host__ __device__ void init(int M, int N, int G_, int c_) { nM = M / BM; nN = N / BM; nwg = nM * nN; G = G_; c = c_; }
    __host__ __device__ bool next(int i, Unit& u) const {
        const long L = (long)i * G + c; if (L >= nwg) return false;
        int wgid = (int)L; { const int q = nwg / NXCD, r = nwg % NXCD, xcd = wgid % NXCD, off = wgid / NXCD; wgid = (xcd < r ? xcd * (q + 1) : r * (q + 1) + (xcd - r) * q) + off; }
        const int nig = WGM * nN, gid = wgid / nig, fm = gid * WGM, gsz = (nM - fm) < WGM ? (nM - fm) : WGM;
        u.pm = fm + ((wgid % nig) % gsz); u.pn = (wgid % nig) / gsz; return true;
    }
    __device__ __forceinline__ void a_ready(const Unit&) const {}
    __device__ __forceinline__ void done(const Unit&) const {}
};

__device__ __forceinline__ unsigned cvt_pk_bf16(float lo, float hi) { unsigned r; asm volatile("v_cvt_pk_bf16_f32 %0, %1, %2" : "=v"(r) : "v"(lo), "v"(hi)); return r; }
typedef float f32x2 __attribute__((ext_vector_type(2)));
typedef unsigned u32x4 __attribute__((ext_vector_type(4)));
struct EpiProj {
    static constexpr bool PERM = true, AFTER_DRAIN = false;
    bf16_t* O; int ldc; unsigned maskA; float sA; unsigned maskB; float sB;
    __device__ __forceinline__ void operator()(const f32x4 (&acc)[2][2][4][2], const Unit& u, int wr, int wc, int fr, int fq) const {
        const float sc = ((maskA >> u.pn) & 1u) ? sA : (((maskB >> u.pn) & 1u) ? sB : 1.f);
        const int row0 = u.pm * BM + wr * 64 + fr, col0 = u.pn * BM + wc * 32 + 8 * fq;
#pragma unroll
        for (int ai = 0; ai < 2; ++ai)
#pragma unroll
            for (int m = 0; m < 4; ++m) { bf16_t* rowp = O + (size_t)(row0 + ai * HALF + m * 16) * ldc + col0;
#pragma unroll
                for (int bj = 0; bj < 2; ++bj) { const f32x4 v0 = acc[ai][bj][m][0] * sc, v1 = acc[ai][bj][m][1] * sc;
                    u32x4 w; w.x = cvt_pk_bf16(v0[0], v0[1]); w.y = cvt_pk_bf16(v0[2], v0[3]); w.z = cvt_pk_bf16(v1[0], v1[1]); w.w = cvt_pk_bf16(v1[2], v1[3]);
                    *(u32x4*)(rowp + bj * HALF) = w; } }
    }
};
struct EpiRes {
    static constexpr bool PERM = false, AFTER_DRAIN = false;
    const float* base; float* out; int ldc;
    __device__ __forceinline__ void operator()(const f32x4 (&acc)[2][2][4][2], const Unit& u, int wr, int wc, int fr, int fq) const {
        const int col0 = u.pn * BM + wc * 32 + 4 * fq;
#pragma unroll
        for (int ai = 0; ai < 2; ++ai)
#pragma unroll
            for (int m = 0; m < 4; ++m) { const size_t off = (size_t)(u.pm * BM + ai * HALF + wr * 64 + m * 16 + fr) * ldc + col0;
#pragma unroll
                for (int bj = 0; bj < 2; ++bj)
#pragma unroll
                    for (int n = 0; n < 2; ++n) { const f32x4 bs = *(const f32x4*)(base + off + bj * HALF + n * 16); *(f32x4*)(out + off + bj * HALF + n * 16) = bs + acc[ai][bj][m][n]; } }
    }
};

struct EpiProjK {
    static constexpr bool PERM = true, AFTER_DRAIN = false;
    bf16_t* O; int ldc; unsigned maskA; float sA; float* kpart; int kpn;
    __device__ __forceinline__ void operator()(const f32x4 (&acc)[2][2][4][2], const Unit& u, int wr, int wc, int fr, int fq) const {
        const float sc = ((maskA >> u.pn) & 1u) ? sA : 1.f;
        const int row0 = u.pm * BM + wr * 64 + fr, col0 = u.pn * BM + wc * 32 + 8 * fq;
#pragma unroll
        for (int ai = 0; ai < 2; ++ai)
#pragma unroll
            for (int m = 0; m < 4; ++m) { bf16_t* rowp = O + (size_t)(row0 + ai * HALF + m * 16) * ldc + col0;
#pragma unroll
                for (int bj = 0; bj < 2; ++bj) { const f32x4 v0 = acc[ai][bj][m][0] * sc, v1 = acc[ai][bj][m][1] * sc;
                    u32x4 w; w.x = cvt_pk_bf16(v0[0], v0[1]); w.y = cvt_pk_bf16(v0[2], v0[3]); w.z = cvt_pk_bf16(v1[0], v1[1]); w.w = cvt_pk_bf16(v1[2], v1[3]);
                    *(u32x4*)(rowp + bj * HALF) = w; } }
        if (u.pn == kpn) {
#pragma unroll
            for (int bj = 0; bj < 2; ++bj)
#pragma unroll
                for (int n = 0; n < 2; ++n) {
                    f32x4 cs = {0.f, 0.f, 0.f, 0.f};
#pragma unroll
                    for (int ai = 0; ai < 2; ++ai)
#pragma unroll
                        for (int m = 0; m < 4; ++m) cs += acc[ai][bj][m][n];
#pragma unroll
                    for (int o = 1; o < 16; o <<= 1) { cs.x += __shfl_xor(cs.x, o); cs.y += __shfl_xor(cs.y, o); cs.z += __shfl_xor(cs.z, o); cs.w += __shfl_xor(cs.w, o); }
                    if (fr == 0) *(f32x4*)(kpart + (size_t)(u.pm * 2 + wr) * 256 + bj * HALF + wc * 32 + 8 * fq + 4 * n) = cs;
                }
        }
    }
};
template <class Epi, class Sched, bool ALIGN_EPI = false, bool SP2 = false>
__device__ __forceinline__ void gemm_phase(PG8_LAS unsigned char* lds, const Gemm g, const Sched& S, const Epi& E) {
    const int tid = threadIdx.x, wid = __builtin_amdgcn_readfirstlane(tid >> 6), lane = tid & 63, wr = wid >> 2, wc = wid & 3, fr = lane & 15, fq = lane >> 4;
    const int K = g.K, nt = K / BK;
    unsigned voffA[2], voffB[2];
#pragma unroll
    for (int i = 0; i < 2; ++i) { int R, C; stage_rc(tid * 16 + i * 8192, R, C); const int Rb = Epi::PERM ? ((R & ~31) + perm32(R & 31)) : R;
        voffA[i] = (unsigned)(R * K + C) * 2u; voffB[i] = (unsigned)(Rb * K + C) * 2u; }
    const size_t kstep = (size_t)(BK * 2);
    const size_t hstep = (size_t)HALF * K * 2;
    const size_t tstep = 2 * hstep;
    const unsigned ldsw = (unsigned)wid * 1024u;
    const int aoff = lds_byte(wr * 64 + fr, fq * 8), boff = lds_byte(wc * 32 + fr, fq * 8);
#define PG8_SA(b, h) (((b) * 2 + (h)) * HTB)
#define PG8_SB(b, h) ((4 + (b) * 2 + (h)) * HTB)
#define PG8_STAGE(bufoff, gbase, voff) do { _Pragma("unroll") for (int _i = 0; _i < 2; ++_i) \
        __builtin_amdgcn_global_load_lds((const unsigned*)((const char*)(gbase) + (voff)[_i]), (PG8_LAS unsigned*)(lds + (bufoff) + ldsw + _i * 8192), 16, 0, 0); } while (0)
#define PG8_LDA(dst, b, h) do { _Pragma("unroll") for (int m = 0; m < 4; ++m) _Pragma("unroll") for (int k = 0; k < 2; ++k) dst[m][k] = *(const PG8_LAS bf16x8*)(lds + PG8_SA(b, h) + aoff + m * 2048 + k * 1024); } while (0)
#define PG8_LDB(dst, b, h) do { _Pragma("unroll") for (int n = 0; n < 2; ++n) _Pragma("unroll") for (int k = 0; k < 2; ++k) dst[n][k] = *(const PG8_LAS bf16x8*)(lds + PG8_SB(b, h) + boff + n * 2048 + k * 1024); } while (0)
#define PG8_MMA(ai, bj, At, Bt) do { __builtin_amdgcn_s_setprio(1); _Pragma("unroll") for (int m = 0; m < 4; ++m) _Pragma("unroll") for (int n = 0; n < 2; ++n) _Pragma("unroll") for (int k = 0; k < 2; ++k) \
        acc[ai][bj][m][n] = __builtin_amdgcn_mfma_f32_16x16x32_bf16(Bt[n][k], At[m][k], acc[ai][bj][m][n], 0, 0, 0); __builtin_amdgcn_s_setprio(0); } while (0)
#define PG8_WAIT_V(n) asm volatile("s_waitcnt vmcnt(" #n ")" ::: "memory")
#define PG8_WAIT_L(n) asm volatile("s_waitcnt lgkmcnt(" #n ")" ::: "memory")
#define PG8_BAR __builtin_amdgcn_s_barrier()
#define PG8_SCHED __builtin_amdgcn_sched_barrier(0)
    Unit cur, nxt; int ui = 0;
    if (!S.next(0, cur)) return;
    f32x4 acc[2][2][4][2];
#pragma unroll
    for (int a = 0; a < 2; ++a)
#pragma unroll
        for (int b = 0; b < 2; ++b)
#pragma unroll
            for (int m = 0; m < 4; ++m)
#pragma unroll
                for (int n = 0; n < 2; ++n) acc[a][b][m][n] = (f32x4){0.f, 0.f, 0.f, 0.f};
    bf16x8 At[4][2], B0[2][2], B1[2][2];
    const char* cA = (const char*)g.A + (size_t)cur.pm * tstep; const char* cB = (const char*)g.Bt + (size_t)cur.pn * tstep;
    S.a_ready(cur);
    if constexpr (SP2) {
        PG8_STAGE(PG8_SB(0, 0), cB, voffB); PG8_STAGE(PG8_SB(0, 1), cB + hstep, voffB); PG8_STAGE(PG8_SA(0, 0), cA, voffA); PG8_STAGE(PG8_SA(0, 1), cA + hstep, voffA);
        if (wr == 1) PG8_BAR;
        PG8_WAIT_V(2); PG8_BAR;
        PG8_STAGE(PG8_SB(1, 0), cB + kstep, voffB); PG8_STAGE(PG8_SA(1, 0), cA + kstep, voffA); PG8_STAGE(PG8_SB(1, 1), cB + hstep + kstep, voffB);
        PG8_WAIT_V(6); PG8_BAR;
    } else {
        PG8_STAGE(PG8_SB(0, 0), cB, voffB); PG8_STAGE(PG8_SA(0, 0), cA, voffA); PG8_STAGE(PG8_SB(0, 1), cB + hstep, voffB); PG8_STAGE(PG8_SA(0, 1), cA + hstep, voffA);
        if (wr == 1) PG8_BAR;
        PG8_WAIT_V(4); PG8_BAR;
        PG8_STAGE(PG8_SB(1, 0), cB + kstep, voffB); PG8_STAGE(PG8_SA(1, 0), cA + kstep, voffA); PG8_STAGE(PG8_SB(1, 1), cB + hstep + kstep, voffB);
        PG8_WAIT_V(6); PG8_BAR;
    }
    for (;;) {
        const bool has_next = S.next(ui + 1, nxt);
        const char* nA = has_next ? (const char*)g.A + (size_t)nxt.pm * tstep : cA; const char* nB = has_next ? (const char*)g.Bt + (size_t)nxt.pn * tstep : cB;
        for (int t = 0; t < nt; t += 2) {
            const bool last = (t == nt - 2);
            const char* a1 = cA + (size_t)(t + 1) * kstep;
            const char* a2 = last ? nA : cA + (size_t)(t + 2) * kstep; const char* b2 = last ? nB : cB + (size_t)(t + 2) * kstep;
            const char* a3 = a2 + kstep; const char* b3 = b2 + kstep;
            if (last && has_next) S.a_ready(nxt);
            if constexpr (SP2) {
            PG8_LDB(B0, 0, 0); PG8_LDB(B1, 0, 1); PG8_SCHED; PG8_LDA(At, 0, 0); PG8_STAGE(PG8_SA(1, 1), a1 + hstep, voffA);
            PG8_WAIT_V(8); PG8_WAIT_L(0); PG8_BAR; PG8_MMA(0, 0, At, B0); PG8_MMA(0, 1, At, B1); PG8_BAR; PG8_SCHED;
            PG8_LDA(At, 0, 1); PG8_STAGE(PG8_SB(0, 0), b2, voffB); PG8_STAGE(PG8_SB(0, 1), b2 + hstep, voffB); PG8_STAGE(PG8_SA(0, 0), a2, voffA);
            PG8_WAIT_V(8); PG8_WAIT_L(0); PG8_BAR; PG8_MMA(1, 0, At, B0); PG8_MMA(1, 1, At, B1); PG8_BAR; PG8_SCHED;
            PG8_LDB(B0, 1, 0); PG8_LDB(B1, 1, 1); PG8_SCHED; PG8_LDA(At, 1, 0); PG8_STAGE(PG8_SA(0, 1), a2 + hstep, voffA);
            PG8_WAIT_V(8); PG8_WAIT_L(0); PG8_BAR; PG8_MMA(0, 0, At, B0); PG8_MMA(0, 1, At, B1); PG8_BAR; PG8_SCHED;
            PG8_LDA(At, 1, 1); PG8_STAGE(PG8_SB(1, 0), b3, voffB); PG8_STAGE(PG8_SB(1, 1), b3 + hstep, voffB); PG8_STAGE(PG8_SA(1, 0), a3, voffA);
            PG8_WAIT_V(8); PG8_WAIT_L(0); PG8_BAR; PG8_MMA(1, 0, At, B0); PG8_MMA(1, 1, At, B1); PG8_BAR; PG8_SCHED;
            } else {
            PG8_LDB(B0, 0, 0); PG8_SCHED; PG8_LDA(At, 0, 0); PG8_STAGE(PG8_SA(1, 1), a1 + hstep, voffA);
            PG8_WAIT_L(8); PG8_BAR; PG8_WAIT_L(0); PG8_MMA(0, 0, At, B0); PG8_BAR; PG8_SCHED;
            PG8_LDB(B1, 0, 1); PG8_STAGE(PG8_SB(0, 0), b2, voffB);
            PG8_BAR; PG8_WAIT_L(0); PG8_MMA(0, 1, At, B1); PG8_BAR;
            PG8_LDA(At, 0, 1); PG8_STAGE(PG8_SA(0, 0), a2, voffA);
            PG8_BAR; PG8_WAIT_L(0); PG8_MMA(1, 0, At, B0); PG8_BAR; PG8_SCHED;
            PG8_STAGE(PG8_SB(0, 1), b2 + hstep, voffB);
            PG8_WAIT_V(6); PG8_BAR; PG8_MMA(1, 1, At, B1); PG8_BAR;
            PG8_LDB(B0, 1, 0); PG8_SCHED; PG8_LDA(At, 1, 0); PG8_STAGE(PG8_SA(0, 1), a2 + hstep, voffA);
            PG8_WAIT_L(8); PG8_BAR; PG8_WAIT_L(0); PG8_MMA(0, 0, At, B0); PG8_BAR; PG8_SCHED;
            PG8_LDB(B1, 1, 1); PG8_STAGE(PG8_SB(1, 0), b3, voffB);
            PG8_BAR; PG8_WAIT_L(0); PG8_MMA(0, 1, At, B1); PG8_BAR;
            PG8_LDA(At, 1, 1); PG8_STAGE(PG8_SA(1, 0), a3, voffA);
            PG8_BAR; PG8_WAIT_L(0); PG8_MMA(1, 0, At, B0); PG8_BAR; PG8_SCHED;
            PG8_STAGE(PG8_SB(1, 1), b3 + hstep, voffB);
            PG8_WAIT_V(6); PG8_BAR; PG8_MMA(1, 1, At, B1); PG8_BAR;
            }
        }
        if constexpr (ALIGN_EPI) { if (wr == 0) PG8_BAR; }
        if constexpr (!Epi::AFTER_DRAIN) { E(acc, cur, wr, wc, fr, fq); S.done(cur); }
        if (!has_next) break;
#pragma unroll
        for (int a = 0; a < 2; ++a)
#pragma unroll
            for (int b = 0; b < 2; ++b)
#pragma unroll
                for (int m = 0; m < 4; ++m)
#pragma unroll
                    for (int n = 0; n < 2; ++n) acc[a][b][m][n] = (f32x4){0.f, 0.f, 0.f, 0.f};
        cur = nxt; cA = nA; cB = nB; ++ui;
        if constexpr (ALIGN_EPI) { if (wr == 1) PG8_BAR; }
    }
    PG8_WAIT_V(0);
    if constexpr (!ALIGN_EPI) { if (wr == 0) PG8_BAR; }
    PG8_BAR;
    if constexpr (Epi::AFTER_DRAIN) { E.fused(acc, cur, wr, wc, fr, fq, lds, wid, lane); S.done(cur); }
#undef PG8_SA
#undef PG8_SB
#undef PG8_STAGE
#undef PG8_LDA
#undef PG8_LDB
#undef PG8_MMA
#undef PG8_WAIT_V
#undef PG8_WAIT_L
#undef PG8_BAR
#undef PG8_SCHED
}
}

constexpr int NWAVES = 8, NTHR = 512;
constexpr int NB = 2, SEQ = 8192, DM = 1024, M = NB * SEQ;
constexpr int EC_SRC = 2832, OC_SRC = 2560, N0 = 2816, N1 = 2560;
constexpr int P0_AQ = 0, P0_AK = 256, P0_AV = 512, P0_AG = 1024, P0_BQ = 1536, P0_BK = 2048, P0_BV = 2176, P0_BG = 2304;
constexpr int P1_CQ = 0, P1_CK = 1024, P1_CV = 1280, P1_CG = 1536;
constexpr float LOG2E = 1.4426950408889634f;
constexpr float EPS = 1e-6f;
constexpr int NPHASE = 13;

constexpr size_t MiB = 1u << 20;
constexpr size_t WS_CTL = 0, CTL_ZERO_BYTES = 64 * 1024;
constexpr size_t WS_KMEAN = 1 * MiB;
constexpr size_t WS_DEC = 1 * MiB + 128 * 1024;
constexpr size_t WS_WT0 = 2 * MiB, WS_WTO0 = 8 * MiB, WS_WT1 = 10 * MiB, WS_WTO1 = 15 * MiB;
constexpr size_t WS_LOGA = 17 * MiB;
constexpr size_t WS_XN = 33 * MiB;
constexpr size_t WS_MIX = 65 * MiB;
constexpr size_t WS_PROJ = 97 * MiB;
constexpr size_t WS_ST = 185 * MiB;
constexpr size_t WS_KPART = WS_KMEAN;
constexpr size_t WS_FARL = 17 * MiB;
constexpr size_t WS_PO0 = 33 * MiB, WS_PO1 = 177 * MiB, WS_PO2 = 209 * MiB;
constexpr size_t WS_ML = 241 * MiB;
constexpr size_t WS_ADJL = 245 * MiB;
constexpr size_t WS_END = 246 * MiB;
constexpr int CW_CNT = 8192;
constexpr size_t DO_KVC = 0;
constexpr size_t DO_GO = 32 * MiB;
constexpr int CW_BAR = 1024;

constexpr int RING_BYTES = 131072;
constexpr int LDSCTL_OFF = RING_BYTES, MISC_OFF = LDSCTL_OFF + 320;
constexpr int LDS_BYTES = 147456;

#define GAS __attribute__((address_space(1)))
#define LAS __attribute__((address_space(3)))
typedef unsigned short bf16;
typedef unsigned v4u __attribute__((ext_vector_type(4)));
typedef unsigned v2u __attribute__((ext_vector_type(2)));
typedef float f32x4 __attribute__((ext_vector_type(4)));
typedef float f32x16 __attribute__((ext_vector_type(16)));
typedef short bf16x8 __attribute__((ext_vector_type(8)));
typedef GAS unsigned gu32;
#define RLX_AGENT __ATOMIC_RELAXED, __HIP_MEMORY_SCOPE_AGENT
#define LDS_WAIT() asm volatile("s_waitcnt lgkmcnt(0)" ::: "memory")
#define VM_WAIT() asm volatile("s_waitcnt vmcnt(0)" ::: "memory")
__device__ __forceinline__ unsigned f2bf(float f) { unsigned u = __builtin_bit_cast(unsigned, f); return (u + 0x7fffu + ((u >> 16) & 1u)) >> 16; }
__device__ __forceinline__ unsigned pk2(float lo, float hi) { return f2bf(lo) | (f2bf(hi) << 16); }
__device__ __forceinline__ float bf2f(bf16 v) { return __builtin_bit_cast(float, (unsigned)v << 16); }
__device__ __forceinline__ float bflo(unsigned w) { return __builtin_bit_cast(float, w << 16); }
__device__ __forceinline__ float bfhi(unsigned w) { return __builtin_bit_cast(float, w & 0xffff0000u); }
__device__ __forceinline__ float wave_sum(float v) {
#pragma unroll
    for (int o = 1; o < 64; o <<= 1) v += __shfl_xor(v, o);
    return v;
}
__device__ __forceinline__ float wave_max(float v) {
#pragma unroll
    for (int o = 1; o < 64; o <<= 1) v = fmaxf(v, __shfl_xor(v, o));
    return v;
}
__device__ __forceinline__ float silu_f(float x) { return x / (1.f + __expf(-x)); }
__device__ __forceinline__ int t5_bucket(int dist) {
    const int n = dist > 0 ? dist : 0;
    if (n < 16) return n;
    const int large = 16 + (int)(logf((float)n / 16.f) / 2.0794415416798357f * 16.f);
    return large < 31 ? large : 31;
}
#define XB_TMO      128
#define XB_XCNT(j)  (256  + 64 * (j))
#define XB_XSUB(j)  (1280 + 64 * (j))
#define XB_XGEN(j)  (2304 + 64 * (j))
#define XB_TOP      3328
#define XB_TOPGEN   3392
#define XCD_BAR_WORDS 3456
#define XB_SPIN_CAP (1u << 18)

__device__ __forceinline__ unsigned xb_ld(unsigned* p)              { return __hip_atomic_load(p, __ATOMIC_RELAXED, __HIP_MEMORY_SCOPE_AGENT); }
__device__ __forceinline__ unsigned xb_add(unsigned* p, unsigned v) { return __hip_atomic_fetch_add(p, v, __ATOMIC_RELAXED, __HIP_MEMORY_SCOPE_AGENT); }
__device__ __forceinline__ unsigned xb_xcc_id() { return (unsigned)__builtin_amdgcn_s_getreg((3 << 11) | 20) & 0xFu; }
#define XB_SPIN(cond, bar) do { unsigned _sp = 0; while (cond) { __builtin_amdgcn_s_sleep(1); \
    if ((++_sp & 255u) == 0u) { if (xb_ld(&(bar)[XB_TMO])) break; if (_sp > XB_SPIN_CAP) { atomicAdd(&(bar)[XB_TMO], 1u); break; } } } } while (0)

struct XcdBarrier {
    unsigned* bar; unsigned x;
    volatile LAS unsigned* st;
};

__device__ __forceinline__ XcdBarrier xcd_barrier_post(unsigned* bar, volatile LAS unsigned* st) {
    XcdBarrier b; b.bar = bar; b.x = xb_xcc_id(); b.st = st;
    if (threadIdx.x == 0) (void)xb_add(&bar[XB_XCNT(b.x)], 1u);
    return b;
}
__device__ __forceinline__ void xcd_barrier_complete(unsigned* bar, unsigned x, unsigned& nloc, unsigned& nx) {
    const unsigned G = gridDim.x * gridDim.y * gridDim.z;
    unsigned sum, cnt, mine, sp = 0u;
    for (;;) {
        sum = 0u; cnt = 0u; mine = 0u;
#pragma unroll
        for (unsigned j = 0; j < 16; ++j) { const unsigned c = xb_ld(&bar[XB_XCNT(j)]); sum += c; cnt += (c > 0u) ? 1u : 0u; mine = (j == x) ? c : mine; }
        if (sum == G) break;
        __builtin_amdgcn_s_sleep(1);
        if ((++sp & 255u) == 0u) { if (xb_ld(&bar[XB_TMO])) break; if (sp > XB_SPIN_CAP) { atomicAdd(&bar[XB_TMO], 1u); break; } }
    }
    nloc = mine > 0u ? mine : 1u; nx = cnt > 0u ? cnt : 1u;
}

__device__ __forceinline__ void xcd_barrier(const XcdBarrier& b) {
    asm volatile("s_waitcnt vmcnt(0)" ::: "memory");
    __syncthreads();
    if (threadIdx.x == 0) {
        unsigned* bar = b.bar;
        __builtin_amdgcn_s_waitcnt(0);
        unsigned nloc = b.st[0], nx = b.st[1];
        if (nloc == 0u) { xcd_barrier_complete(bar, b.x, nloc, nx); b.st[0] = nloc; b.st[1] = nx; }
        const unsigned old = xb_add(&bar[XB_XSUB(b.x)], 1u);
        const unsigned gen = old / nloc;
        if (old + 1u == (gen + 1u) * nloc) {
            __builtin_amdgcn_fence(__ATOMIC_RELEASE, "agent");
            asm volatile("s_waitcnt vmcnt(0)" ::: "memory");
            const unsigned og = xb_add(&bar[XB_TOP], 1u);
            const unsigned tg = og / nx;
            if (og + 1u == (tg + 1u) * nx) xb_add(&bar[XB_TOPGEN], 1u);
            else XB_SPIN(xb_ld(&bar[XB_TOPGEN]) == tg, bar);
            __builtin_amdgcn_fence(__ATOMIC_ACQUIRE, "agent");
            xb_add(&bar[XB_XGEN(b.x)], 1u);
            asm volatile("s_waitcnt vmcnt(0)" ::: "memory");
        } else {
            XB_SPIN(xb_ld(&bar[XB_XGEN(b.x)]) == gen, bar);
            __builtin_amdgcn_fence(__ATOMIC_ACQUIRE, "agent");
            asm volatile("s_waitcnt vmcnt(0)" ::: "memory");
        }
    }
    __syncthreads();
}

struct Args { const float* in[12]; float* out; unsigned char* ws; };
struct Frame {
    LAS unsigned char* lds;
    volatile LAS unsigned* MISC;
    int tid, lane, wave, vcu, G;
    const Args* a;
    unsigned char* ws; float* out;
};
#define F_x          (F.a->in[0])
#define F_norm_gain  (F.a->in[1])
#define F_final_gain (F.a->in[2])
#define F_rel_bias   (F.a->in[3])
#define F_w_in_even  (F.a->in[4])
#define F_gla_w_up   (F.a->in[5])
#define F_gla_b_up   (F.a->in[6])
#define F_gla_gain   (F.a->in[7])
#define F_sinks      (F.a->in[8])
#define F_w_out_even (F.a->in[9])
#define F_w_in_odd   (F.a->in[10])
#define F_w_out_odd  (F.a->in[11])
#define F_WT0   ((bf16*)(F.ws + WS_WT0))
#define F_WTO0  ((bf16*)(F.ws + WS_WTO0))
#define F_WT1   ((bf16*)(F.ws + WS_WT1))
#define F_WTO1  ((bf16*)(F.ws + WS_WTO1))
#define F_XN    ((bf16*)(F.ws + WS_XN))
#define F_MIX   ((bf16*)(F.ws + WS_MIX))
#define F_PROJ  ((bf16*)(F.ws + WS_PROJ))
#define F_ST    ((bf16*)(F.ws + WS_ST))
#define F_LOGA  ((float*)(F.ws + WS_LOGA))
#define F_KMEAN ((float*)(F.ws + WS_KMEAN))
#define F_DEC   ((float*)(F.ws + WS_DEC))
#define F_KVC   ((float*)((unsigned char*)F.out + DO_KVC))
#define F_GO    ((float*)((unsigned char*)F.out + DO_GO))
#define PHASE_ENTER() do { asm volatile("" : "+s"(F.ws), "+s"(F.out)); } while (0)


__device__ __forceinline__ void p0_transpose_item(const float* W, int ldw, int K, bf16* WT, int k0, int n_src0, int n_dst0, LAS float* scr, int lane) {
#pragma unroll 8
    for (int i = 0; i < 32; ++i) { const int kk = 2 * i + (lane >> 5); scr[kk * 33 + (lane & 31)] = W[(size_t)(k0 + kk) * ldw + n_src0 + (lane & 31)]; }
    LDS_WAIT(); asm volatile("" ::: "memory");
    const int c = lane & 7;
#pragma unroll
    for (int j = 0; j < 4; ++j) { const int n = (lane >> 3) + 8 * j; const LAS float* s = scr + (8 * c) * 33 + n;
        v4u o; o.x = pk2(s[0 * 33], s[1 * 33]); o.y = pk2(s[2 * 33], s[3 * 33]); o.z = pk2(s[4 * 33], s[5 * 33]); o.w = pk2(s[6 * 33], s[7 * 33]);
        *(GAS v4u*)(WT + (size_t)(n_dst0 + n) * K + k0 + 8 * c) = o; }
    LDS_WAIT(); asm volatile("" ::: "memory");
}
__device__ __forceinline__ void rms_row_to_bf16(const float* xrow, const float* g, bf16* orow, int lane) {
    const GAS f32x4* xr = (const GAS f32x4*)xrow + lane;
    const GAS f32x4* gr = (const GAS f32x4*)g + lane;
    f32x4 v[4]; float s = 0.f;
#pragma unroll
    for (int j = 0; j < 4; ++j) { v[j] = xr[64 * j]; s += (v[j].x * v[j].x + v[j].y * v[j].y) + (v[j].z * v[j].z + v[j].w * v[j].w); }
    const float rs = 1.0f / sqrtf(wave_sum(s) * (1.f / DM) + EPS);
    GAS unsigned long long* o8 = (GAS unsigned long long*)orow + lane;
#pragma unroll
    for (int j = 0; j < 4; ++j) { const f32x4 gg = gr[64 * j];
        o8[64 * j] = (unsigned long long)pk2(v[j].x * rs * gg.x, v[j].y * rs * gg.y) | ((unsigned long long)pk2(v[j].z * rs * gg.z, v[j].w * rs * gg.w) << 32); }
}
__device__ __forceinline__ void p0_prologue(Frame& F) {
    LAS float* scr = (LAS float*)(F.lds + F.wave * 16384);
    const int gw = F.vcu * NWAVES + F.wave, NGW = F.G * NWAVES;
    constexpr int KB = DM / 64;
    constexpr int I_0 = KB * (N0 / 32), I_O = KB * (DM / 32), I_1 = KB * (N1 / 32);
    constexpr int NITEMS = I_0 + I_O + I_1 + I_O;
    for (int it = gw; it < NITEMS; it += NGW) {
        int r = it;
        if (r < I_0) { const int kb = r / (N0 / 32), nb = r % (N0 / 32), nd = nb * 32, ns = nd + (nd >= 1024 ? 16 : 0);
            p0_transpose_item(F_w_in_even, EC_SRC, DM, F_WT0, kb * 64, ns, nd, scr, F.lane); continue; } r -= I_0;
        if (r < I_O) { const int kb = r / (DM / 32), nb = r % (DM / 32); p0_transpose_item(F_w_out_even, DM, DM, F_WTO0, kb * 64, nb * 32, nb * 32, scr, F.lane); continue; } r -= I_O;
        if (r < I_1) { const int kb = r / (N1 / 32), nb = r % (N1 / 32); p0_transpose_item(F_w_in_odd, OC_SRC, DM, F_WT1, kb * 64, nb * 32, nb * 32, scr, F.lane); continue; } r -= I_1;
        { const int kb = r / (DM / 32), nb = r % (DM / 32); p0_transpose_item(F_w_out_odd, DM, DM, F_WTO1, kb * 64, nb * 32, nb * 32, scr, F.lane); }
    }
    __syncthreads();
    LAS float* WdT = (LAS float*)(F.lds);
    LAS float* Wup = (LAS float*)(F.lds + 65536);
    LAS float* Bup = (LAS float*)(F.lds + 65536 + 16384);
    for (int i = F.tid; i < 16 * 1024; i += NTHR) { const int k = i >> 4, r = i & 15; WdT[r * 1024 + k] = F_w_in_even[(size_t)k * EC_SRC + 1024 + r]; }
    for (int i = F.tid; i < 16 * 256; i += NTHR) Wup[i] = F_gla_w_up[i];
    for (int i = F.tid; i < 256; i += NTHR) Bup[i] = F_gla_b_up[i];
    __syncthreads();
    const int lane = F.lane;
    for (int m = gw; m < M; m += NGW) {
        const GAS f32x4* xr = (const GAS f32x4*)(F_x + (size_t)m * DM) + lane;
        const GAS f32x4* gr = (const GAS f32x4*)F_norm_gain + lane;
        f32x4 v[4]; float s = 0.f;
#pragma unroll
        for (int j = 0; j < 4; ++j) { v[j] = xr[64 * j]; s += (v[j].x * v[j].x + v[j].y * v[j].y) + (v[j].z * v[j].z + v[j].w * v[j].w); }
        const float rs = 1.0f / sqrtf(wave_sum(s) * (1.f / DM) + EPS);
        GAS unsigned long long* o8 = (GAS unsigned long long*)(F_XN + (size_t)m * DM) + lane;
#pragma unroll
        for (int j = 0; j < 4; ++j) { const f32x4 gg = gr[64 * j]; v[j].x *= rs * gg.x; v[j].y *= rs * gg.y; v[j].z *= rs * gg.z; v[j].w *= rs * gg.w;
            o8[64 * j] = (unsigned long long)pk2(v[j].x, v[j].y) | ((unsigned long long)pk2(v[j].z, v[j].w) << 32); }
        f32x4 z = *(const LAS f32x4*)(Bup + 4 * lane);
#pragma unroll 2
        for (int r = 0; r < 16; ++r) { float a = 0.f;
#pragma unroll
            for (int j = 0; j < 4; ++j) { const f32x4 w = *(const LAS f32x4*)(WdT + r * 1024 + 256 * j + 4 * lane); a += (v[j].x * w.x + v[j].y * w.y) + (v[j].z * w.z + v[j].w * w.w); }
            const float ad = wave_sum(a);
            const f32x4 wu = *(const LAS f32x4*)(Wup + r * 256 + 4 * lane); z += ad * wu; }
        f32x4 la;
#pragma unroll
        for (int i = 0; i < 4; ++i) la[i] = (fminf(z[i], 0.f) - log1pf(__expf(-fabsf(z[i])))) * (1.0f / 16.0f);
        *((GAS f32x4*)(F_LOGA + (size_t)m * 256) + lane) = la;
    }
}

__device__ __forceinline__ void p2_gla_naive(Frame& F) {
    for (int u = blockIdx.x; u < 256; u += F.G) {
        const int bh = u >> 5, b = bh >> 2, h = bh & 3, e = (u & 31) * 4 + F.wave, d = F.lane;
        if (F.wave < 4) {
            float st = 0.f;
#pragma unroll 8
            for (int t = 0; t < SEQ; ++t) {
                const size_t row = (size_t)b * SEQ + t;
                const bf16* pr = F_PROJ + row * N0;
                const float q = bf2f(pr[P0_AQ + h * 64 + d]), k = bf2f(pr[P0_AK + h * 64 + d]), v = bf2f(pr[P0_AV + h * 128 + e]);
                const float alpha = __expf(F_LOGA[row * 256 + h * 64 + d]);
                st = alpha * st + k * v;
                const float o = wave_sum(q * st);
                if (d == 0) F_GO[row * 512 + h * 128 + e] = o;
            }
        }
    }
}
__device__ __forceinline__ void p4_gla_post_naive(Frame& F) {
    const int gw = F.vcu * NWAVES + F.wave, NGW = F.G * NWAVES, lane = F.lane;
    for (int it = gw; it < M * 4; it += NGW) {
        const int row = it >> 2, h = it & 3;
        const float* o = F_GO + (size_t)row * 512 + h * 128;
        const float a = o[lane], c = o[lane + 64];
        const float rs = 1.0f / sqrtf(wave_sum(a * a + c * c) * (1.0f / 128.f) + EPS);
        const bf16* g = F_PROJ + (size_t)row * N0 + P0_AG + h * 128;
        bf16* mo = F_MIX + (size_t)row * DM + h * 128;
        mo[lane] = (bf16)f2bf(a * rs * F_gla_gain[lane] * silu_f(bf2f(g[lane])));
        mo[lane + 64] = (bf16)f2bf(c * rs * F_gla_gain[lane + 64] * silu_f(bf2f(g[lane + 64])));
    }
}
__device__ __forceinline__ void p3_swa_naive(Frame& F) {
    for (int gid = blockIdx.x * NTHR + F.tid; gid < M * 8; gid += F.G * NTHR) {
        const int h = gid & 7, row = gid >> 3, b = row / SEQ, t = row % SEQ, kvh = h >> 2;
        const bf16* pr = F_PROJ + (size_t)row * N0;
        float q[64];
#pragma unroll
        for (int i = 0; i < 64; ++i) q[i] = bf2f(pr[P0_BQ + h * 64 + i]);
        float m = F_sinks[h] * LOG2E, l = 1.f, o[64];
#pragma unroll
        for (int i = 0; i < 64; ++i) o[i] = 0.f;
        const int j0 = t - 127 > 0 ? t - 127 : 0;
        for (int j = j0; j <= t; ++j) {
            const bf16* kr = F_PROJ + (size_t)(b * SEQ + j) * N0 + P0_BK + kvh * 64;
            const bf16* vr = F_PROJ + (size_t)(b * SEQ + j) * N0 + P0_BV + kvh * 64;
            float s = 0.f;
#pragma unroll
            for (int i = 0; i < 64; ++i) s += q[i] * bf2f(kr[i]);
            s += F_rel_bias[t5_bucket(t - j) * 8 + h] * LOG2E;
            const float mn = fmaxf(m, s), f = exp2f(m - mn), p = exp2f(s - mn);
            l = l * f + p; m = mn;
#pragma unroll
            for (int i = 0; i < 64; ++i) o[i] = o[i] * f + p * bf2f(vr[i]);
        }
        const float inv = 1.f / l;
#pragma unroll
        for (int i = 0; i < 64; ++i) F_MIX[(size_t)row * DM + 512 + h * 64 + i] = (bf16)f2bf(o[i] * inv * silu_f(bf2f(pr[P0_BG + h * 64 + i])));
    }
}
__device__ __forceinline__ void p8_kmean_naive(Frame& F) {
    for (int gid = blockIdx.x * NTHR + F.tid; gid < 128 * 128; gid += F.G * NTHR) {
        const int item = gid >> 7, d = gid & 127, n = item & 31, bk = item >> 5, b = bk >> 1, kvh = bk & 1;
        float s = 0.f;
        for (int r = 0; r < 256; ++r) s += bf2f(F_PROJ[(size_t)(b * SEQ + n * 256 + r) * N1 + P1_CK + kvh * 128 + d]);
        F_KMEAN[(size_t)item * 128 + d] = s * (1.0f / 256.f);
    }
}
__device__ __forceinline__ void p9_moba_naive(Frame& F) {
    LAS float* qs = (LAS float*)(F.lds) + F.wave * 128;
    const int gw = F.vcu * NWAVES + F.wave, NGW = F.G * NWAVES, lane = F.lane;
    for (int item = gw; item < M * 8; item += NGW) {
        const int h = item & 7, row = item >> 3, b = row / SEQ, t = row % SEQ, kvh = h >> 2, own = t >> 8;
        const bf16* pr = F_PROJ + (size_t)row * N1;
        LDS_WAIT();
        qs[lane] = bf2f(pr[P1_CQ + h * 128 + lane]); qs[lane + 64] = bf2f(pr[P1_CQ + h * 128 + lane + 64]);
        LDS_WAIT(); asm volatile("" ::: "memory");
        const LAS f32x4* q4 = (const LAS f32x4*)qs;
        float gate = -INFINITY;
        if (lane < own) { const GAS f32x4* km = (const GAS f32x4*)(F_KMEAN + ((size_t)((b * 2 + kvh) * 32 + lane)) * 128); float s = 0.f;
            for (int i = 0; i < 32; ++i) { const f32x4 a = q4[i], c = km[i]; s += (a.x * c.x + a.y * c.y) + (a.z * c.z + a.w * c.w); } gate = s; }
        int s0 = -1, s1 = -1, s2 = -1;
#pragma unroll
        for (int r = 0; r < 3; ++r) {
            const float mx = wave_max(gate);
            int idx = -1;
            if (mx != -INFINITY) { const unsigned long long bal = __ballot(gate == mx); idx = __ffsll((long long)bal) - 1; if (lane == idx) gate = -INFINITY; }
            if (r == 0) s0 = idx; else if (r == 1) s1 = idx; else s2 = idx;
        }
        float m = -INFINITY, l = 0.f, o0 = 0.f, o1 = 0.f;
        for (int si = 0; si < 4; ++si) {
            const int blk = si == 0 ? s0 : (si == 1 ? s1 : (si == 2 ? s2 : own));
            if (blk < 0) continue;
            for (int c = 0; c < 4; ++c) {
                const int kpos = blk * 256 + c * 64 + lane;
                float s = -INFINITY;
                if (kpos <= t) {
                    const GAS v4u* kr = (const GAS v4u*)(F_PROJ + (size_t)(b * SEQ + kpos) * N1 + P1_CK + kvh * 128);
                    float a = 0.f;
                    for (int i = 0; i < 16; ++i) { const v4u kk = kr[i]; const f32x4 qa = q4[2 * i], qb = q4[2 * i + 1];
                        a += (qa.x * bflo(kk.x) + qa.y * bfhi(kk.x)) + (qa.z * bflo(kk.y) + qa.w * bfhi(kk.y)) + (qb.x * bflo(kk.z) + qb.y * bfhi(kk.z)) + (qb.z * bflo(kk.w) + qb.w * bfhi(kk.w)); }
                    s = a + F_rel_bias[t5_bucket(t - kpos) * 8 + h] * LOG2E;
                }
                const float cm = wave_max(s);
                if (cm == -INFINITY) continue;
                const float mn = fmaxf(m, cm), f = exp2f(m - mn), p = exp2f(s - mn);
                l = l * f + wave_sum(p); m = mn; o0 *= f; o1 *= f;
                for (int j = 0; j < 64; ++j) {
                    const float pj = __shfl(p, j);
                    const unsigned vv = *(const GAS unsigned*)(F_PROJ + (size_t)(b * SEQ + blk * 256 + c * 64 + j) * N1 + P1_CV + kvh * 128 + 2 * lane);
                    o0 += pj * bflo(vv); o1 += pj * bfhi(vv);
                }
            }
        }
        const float inv = 1.f / l;
        const unsigned gg = *(const GAS unsigned*)(pr + P1_CG + h * 128 + 2 * lane);
        *(GAS unsigned*)(F_MIX + (size_t)row * DM + h * 128 + 2 * lane) = pk2(o0 * inv * silu_f(bflo(gg)), o1 * inv * silu_f(bfhi(gg)));
    }
}
__device__ __forceinline__ void p_rms_rows_bf16(Frame& F, const float* src, const float* g, bf16* dst) {
    const int gw = F.vcu * NWAVES + F.wave, NGW = F.G * NWAVES;
    for (int m = gw; m < M; m += NGW) rms_row_to_bf16(src + (size_t)m * DM, g, dst + (size_t)m * DM, F.lane);
}
__device__ __forceinline__ void p_rms_rows_f32_inplace(Frame& F, float* buf, const float* g) {
    const int gw = F.vcu * NWAVES + F.wave, NGW = F.G * NWAVES, lane = F.lane;
    for (int m = gw; m < M; m += NGW) {
        GAS f32x4* xr = (GAS f32x4*)(buf + (size_t)m * DM) + lane;
        const GAS f32x4* gr = (const GAS f32x4*)g + lane;
        f32x4 v[4]; float s = 0.f;
#pragma unroll
        for (int j = 0; j < 4; ++j) { v[j] = xr[64 * j]; s += (v[j].x * v[j].x + v[j].y * v[j].y) + (v[j].z * v[j].z + v[j].w * v[j].w); }
        const float rs = 1.0f / sqrtf(wave_sum(s) * (1.f / DM) + EPS);
#pragma unroll
        for (int j = 0; j < 4; ++j) { const f32x4 gg = gr[64 * j]; f32x4 o; o.x = v[j].x * rs * gg.x; o.y = v[j].y * rs * gg.y; o.z = v[j].z * rs * gg.z; o.w = v[j].w * rs * gg.w; xr[64 * j] = o; }
    }
}

typedef float f32x2_t __attribute__((ext_vector_type(2)));
typedef __bf16 bf16x2_t __attribute__((ext_vector_type(2)));
typedef short v4i16_t __attribute__((ext_vector_type(4)));
__device__ __forceinline__ unsigned cvtpk(float lo, float hi) { f32x2_t v = {lo, hi}; bf16x2_t b = __builtin_convertvector(v, bf16x2_t); return __builtin_bit_cast(unsigned, b); }
__device__ __forceinline__ int crow(int r, int hi) { return (r & 3) + 8 * (r >> 2) + 4 * hi; }
#define MFMA32(a, b, c) __builtin_amdgcn_mfma_f32_32x32x16_bf16((a), (b), (c), 0, 0, 0)
__device__ __forceinline__ bf16x8 pack8(const f32x16& x, int s) {
    v4u p; p.x = cvtpk(x[8 * s + 0], x[8 * s + 1]); p.y = cvtpk(x[8 * s + 2], x[8 * s + 3]); p.z = cvtpk(x[8 * s + 4], x[8 * s + 5]); p.w = cvtpk(x[8 * s + 6], x[8 * s + 7]);
    return __builtin_bit_cast(bf16x8, p);
}
__device__ __forceinline__ v4i16_t tr_read(LAS unsigned char* p) { return __builtin_amdgcn_ds_read_tr16_b64_v4i16((LAS v4i16_t*)p); }
__device__ __forceinline__ bf16x8 join4(v4i16_t lo, v4i16_t hi) { return (bf16x8){lo[0], lo[1], lo[2], lo[3], hi[0], hi[1], hi[2], hi[3]}; }
__device__ __forceinline__ float ex2(float x) { return __builtin_amdgcn_exp2f(x); }

constexpr int SWA_K = 0, SWA_V = 32768, SWA_BIAS = 65536, SWA_WSF = 67584, SWA_STG = 68608, SWA_STG_W = 4608;
__device__ __forceinline__ int swa_offK(int r, int ch) { return 128 * r + 16 * (ch ^ ((r >> 1) & 7)); }
__device__ __forceinline__ int swa_offV(int r, int ch) { return 128 * r + 16 * (ch ^ (((r >> 1) & 1) << 2)); }
__device__ __forceinline__ void p_swa(Frame& F) {
    const int tid = F.tid, lane = F.lane, wave = F.wave, c = lane & 31, hi = lane >> 5;
    const int tq = (lane & 15) >> 2, tp = lane & 3, tblk = (lane >> 4) & 1;
    LAS float* biasL = (LAS float*)(F.lds + SWA_BIAS);
    LAS float* wsf = (LAS float*)(F.lds + SWA_WSF) + wave * 32;
    LAS float* stg = (LAS float*)(F.lds + SWA_STG + wave * SWA_STG_W);
    for (int u = blockIdx.x; u < 256; u += F.G) {
        const int nb = u & 63, bk = u >> 6, b = bk >> 1, kvh = bk & 1;
        __syncthreads();
#pragma unroll
        for (int i = 0; i < 4; ++i) {
            const int idx = tid + NTHR * i, r = idx >> 3, ch = idx & 7, kpos = (nb - 1) * 128 + r;
            v4u kk = {0u, 0u, 0u, 0u}, vv = {0u, 0u, 0u, 0u};
            if (kpos >= 0) { const bf16* src = F_PROJ + (size_t)(b * SEQ + kpos) * N0 + kvh * 64 + ch * 8; kk = *(const GAS v4u*)(src + P0_BK); vv = *(const GAS v4u*)(src + P0_BV); }
            *(LAS v4u*)(F.lds + SWA_K + swa_offK(r, ch)) = kk;
            *(LAS v4u*)(F.lds + SWA_V + swa_offV(r, ch)) = vv;
        }
        { const int g = tid >> 7, dist = tid & 127; biasL[tid] = F_rel_bias[t5_bucket(dist) * 8 + kvh * 4 + g] * LOG2E; }
        __syncthreads();
        const int g = wave >> 1, head = kvh * 4 + g, qh = wave & 1;
        const float sink2 = F_sinks[head] * LOG2E;
#pragma unroll 1
        for (int i = 0; i < 2; ++i) {
            const int q0 = 64 * qh + 32 * i, kt0 = q0 >> 5;
            const size_t rowbase = (size_t)b * SEQ + nb * 128 + q0;
            bf16x8 qf[4];
            { const bf16* qp = F_PROJ + (rowbase + c) * N0 + P0_BQ + head * 64 + 8 * hi;
#pragma unroll
              for (int ks = 0; ks < 4; ++ks) qf[ks] = *(const GAS bf16x8*)(qp + 16 * ks); }
            f32x16 st[5];
#pragma unroll
            for (int kk = 0; kk < 5; ++kk) {
                f32x16 acc = {};
                const int kr = 32 * (kt0 + kk) + c;
#pragma unroll
                for (int ks = 0; ks < 4; ++ks) { const bf16x8 kf = *(const LAS bf16x8*)(F.lds + SWA_K + swa_offK(kr, 2 * ks + hi)); acc = MFMA32(kf, qf[ks], acc); }
                st[kk] = acc;
            }
            float m = sink2;
#pragma unroll
            for (int kk = 0; kk < 5; ++kk)
#pragma unroll
                for (int r = 0; r < 16; ++r) {
                    const int keyl = crow(r, hi), dist = 128 + c - 32 * kk - keyl;
                    bool ok = true;
                    if (kk == 0) ok = dist < 128;
                    if (kk == 4) ok = dist >= 0;
                    ok = ok && (nb > 0 || 32 * (kt0 + kk) + keyl >= 128);
                    const float s = ok ? st[kk][r] + biasL[g * 128 + (dist & 127)] : -INFINITY;
                    st[kk][r] = s; m = fmaxf(m, s);
                }
            m = fmaxf(m, __shfl_xor(m, 32));
            float l = 0.f;
#pragma unroll
            for (int kk = 0; kk < 5; ++kk)
#pragma unroll
                for (int r = 0; r < 16; ++r) { const float p = ex2(st[kk][r] - m); st[kk][r] = p; l += p; }
            l += __shfl_xor(l, 32);
            l += ex2(sink2 - m);
            f32x16 o[2]; o[0] = (f32x16){}; o[1] = (f32x16){};
#pragma unroll
            for (int kk = 0; kk < 5; ++kk)
#pragma unroll
                for (int s2 = 0; s2 < 2; ++s2) {
                    const bf16x8 pf = pack8(st[kk], s2);
                    const int vr = 32 * (kt0 + kk) + 16 * s2 + 4 * hi + tq;
#pragma unroll
                    for (int dt = 0; dt < 2; ++dt) {
                        const int ch = 4 * dt + 2 * tblk + (tp >> 1);
                        const v4i16_t lo = tr_read(F.lds + SWA_V + swa_offV(vr, ch) + 8 * (tp & 1));
                        const v4i16_t hh = tr_read(F.lds + SWA_V + swa_offV(vr + 8, ch) + 8 * (tp & 1));
                        o[dt] = MFMA32(pf, join4(lo, hh), o[dt]);
                    }
                }
            if (hi == 0) wsf[c] = 1.0f / l;
            LDS_WAIT(); asm volatile("" ::: "memory");
#pragma unroll
            for (int r = 0; r < 16; ++r) { const float inv = wsf[crow(r, hi)]; o[0][r] *= inv; o[1][r] *= inv; }
#pragma unroll
            for (int dt = 0; dt < 2; ++dt) {
#pragma unroll
                for (int r = 0; r < 16; ++r) stg[crow(r, hi) * 36 + c] = o[dt][r];
                LDS_WAIT(); asm volatile("" ::: "memory");
#pragma unroll
                for (int i4 = 0; i4 < 4; ++i4) {
                    const int rr = i4 * 8 + (lane >> 3), ch = lane & 7;
                    const f32x4 v = *(const LAS f32x4*)(stg + rr * 36 + ch * 4);
                    const size_t grow = rowbase + rr; const int col = head * 64 + 32 * dt + ch * 4;
                    const v2u gg = *(const GAS v2u*)(F_PROJ + grow * N0 + P0_BG + col);
                    v2u ov; ov.x = cvtpk(v.x * silu_f(bflo(gg.x)), v.y * silu_f(bfhi(gg.x))); ov.y = cvtpk(v.z * silu_f(bflo(gg.y)), v.w * silu_f(bfhi(gg.y)));
                    *(GAS v2u*)(F_MIX + grow * DM + 512 + col) = ov;
                }
                LDS_WAIT(); asm volatile("" ::: "memory");
            }
        }
    }
}
constexpr int GA_QE = 0, GA_KE = 9216, GA_KPT = 18432, GA_VT = 27648, GA_TOT = 46080;
__device__ __forceinline__ void p_gla_a(Frame& F) {
    const int tid = F.tid, lane = F.lane, wave = F.wave, c = lane & 31, hi = lane >> 5;
    const int d = tid & 63, part = wave;
    LAS float* TOT = (LAS float*)(F.lds + GA_TOT);
    for (int u = blockIdx.x; u < 1024; u += F.G) {
        const int n = u & 127, bh = u >> 7, b = bh >> 2, h = bh & 3;
        const size_t row0 = (size_t)b * SEQ + n * 64;
        __syncthreads();
        float la[8]; bf16 qv[8], kv[8];
#pragma unroll
        for (int i = 0; i < 8; ++i) { const size_t row = row0 + part * 8 + i; la[i] = F_LOGA[row * 256 + h * 64 + d]; const bf16* pr = F_PROJ + row * N0 + h * 64 + d; qv[i] = pr[P0_AQ]; kv[i] = pr[P0_AK]; }
#pragma unroll
        for (int j = 0; j < 2; ++j) {
            const int idx = tid + NTHR * j, cr = idx >> 4, ch = idx & 15;
            const v4u vv = *(const GAS v4u*)(F_PROJ + (row0 + cr) * N0 + P0_AV + h * 128 + ch * 8);
            LAS bf16* vt = (LAS bf16*)(F.lds + GA_VT) + (ch * 8) * 72 + cr;
            vt[0 * 72] = (bf16)(vv.x & 0xffffu); vt[1 * 72] = (bf16)(vv.x >> 16); vt[2 * 72] = (bf16)(vv.y & 0xffffu); vt[3 * 72] = (bf16)(vv.y >> 16);
            vt[4 * 72] = (bf16)(vv.z & 0xffffu); vt[5 * 72] = (bf16)(vv.z >> 16); vt[6 * 72] = (bf16)(vv.w & 0xffffu); vt[7 * 72] = (bf16)(vv.w >> 16);
        }
        { float p = 0.f;
#pragma unroll
          for (int i = 0; i < 8; ++i) { p += la[i]; la[i] = p; }
          TOT[part * 64 + d] = p; }
        __syncthreads();
        float off = 0.f, blast = 0.f;
#pragma unroll
        for (int pp = 0; pp < 8; ++pp) { const float t = TOT[pp * 64 + d]; blast += t; if (pp < part) off += t; }
        v4u kpw;
        {   unsigned kp[8];
#pragma unroll
            for (int i = 0; i < 8; ++i) {
                const float bc = off + la[i]; const int cc = part * 8 + i;
                const float qf = bf2f(qv[i]), kf = bf2f(kv[i]);
                ((LAS bf16*)(F.lds + GA_QE))[cc * 72 + d] = (bf16)f2bf(qf * __expf(bc));
                ((LAS bf16*)(F.lds + GA_KE))[cc * 72 + d] = (bf16)f2bf(kf * __expf(-bc));
                kp[i] = f2bf(kf * __expf(blast - bc));
            }
            kpw.x = kp[0] | (kp[1] << 16); kpw.y = kp[2] | (kp[3] << 16); kpw.z = kp[4] | (kp[5] << 16); kpw.w = kp[6] | (kp[7] << 16);
        }
        *(LAS v4u*)(F.lds + GA_KPT + d * 144 + part * 16) = kpw;
        if (part == 0) F_DEC[u * 64 + d] = __expf(blast);
        __syncthreads();
        const int et = wave >> 1, ct = wave & 1;
        f32x16 oacc = {};
#pragma unroll
        for (int st = 0; st < 2; ++st) {
            if (st <= ct) {
                f32x16 x = {};
#pragma unroll
                for (int ks = 0; ks < 4; ++ks) {
                    const bf16x8 A = *(const LAS bf16x8*)(F.lds + GA_KE + (32 * st + c) * 144 + 32 * ks + 16 * hi);
                    const bf16x8 B = *(const LAS bf16x8*)(F.lds + GA_QE + (32 * ct + c) * 144 + 32 * ks + 16 * hi);
                    x = MFMA32(A, B, x);
                }
                if (st == ct) {
#pragma unroll
                    for (int r = 0; r < 16; ++r) if (crow(r, hi) > c) x[r] = 0.f;
                }
#pragma unroll
                for (int s2 = 0; s2 < 2; ++s2) {
                    const bf16x8 xs = pack8(x, s2);
                    const int addr = GA_VT + (32 * et + c) * 144 + 64 * st + 32 * s2 + 8 * hi;
                    const v2u lo = *(const LAS v2u*)(F.lds + addr), hh = *(const LAS v2u*)(F.lds + addr + 16);
                    v4u pa; pa.x = lo.x; pa.y = lo.y; pa.z = hh.x; pa.w = hh.y;
                    oacc = MFMA32(__builtin_bit_cast(bf16x8, pa), xs, oacc);
                }
            }
        }
        { float* oi = F_GO + ((size_t)u * 8 + wave) * 1024 + lane * 4;
#pragma unroll
          for (int i4 = 0; i4 < 4; ++i4) { f32x4 v; v.x = oacc[4 * i4]; v.y = oacc[4 * i4 + 1]; v.z = oacc[4 * i4 + 2]; v.w = oacc[4 * i4 + 3]; *(GAS f32x4*)(oi + i4 * 256) = v; } }
        f32x16 kvacc = {};
#pragma unroll
        for (int ks = 0; ks < 4; ++ks) {
            const bf16x8 A = *(const LAS bf16x8*)(F.lds + GA_VT + (32 * et + c) * 144 + 32 * ks + 16 * hi);
            const bf16x8 B = *(const LAS bf16x8*)(F.lds + GA_KPT + (32 * ct + c) * 144 + 32 * ks + 16 * hi);
            kvacc = MFMA32(A, B, kvacc);
        }
        { float* kc = F_KVC + (size_t)u * 8192 + (32 * et) * 64 + 32 * ct + c;
#pragma unroll
          for (int r = 0; r < 16; ++r) kc[crow(r, hi) * 64] = kvacc[r]; }
        { const int cr = tid >> 3, ch = tid & 7; const v4u v = *(const LAS v4u*)(F.lds + GA_QE + cr * 144 + ch * 16);
          *(GAS v4u*)(F_PROJ + (row0 + cr) * N0 + P0_AQ + h * 64 + ch * 8) = v; }
    }
}
__device__ __forceinline__ void p_gla_scan(Frame& F) {
    if (F.tid < 256) {
        for (int idx = blockIdx.x * 256 + F.tid; idx < 65536; idx += F.G * 256) {
            const int bh = idx >> 13, ed = idx & 8191, dd = ed & 63;
            const float* kv = F_KVC + (size_t)bh * 128 * 8192 + ed; const float* dc = F_DEC + bh * 128 * 64 + dd; bf16* st = F_ST + (size_t)bh * 128 * 8192 + ed;
            float s = 0.f;
            for (int n0 = 0; n0 < 128; n0 += 16) {
                float kvv[16], dv[16];
#pragma unroll
                for (int j = 0; j < 16; ++j) { kvv[j] = kv[(size_t)(n0 + j) * 8192]; dv[j] = dc[(n0 + j) * 64]; }
#pragma unroll
                for (int j = 0; j < 16; ++j) { st[(size_t)(n0 + j) * 8192] = (bf16)f2bf(s); s = dv[j] * s + kvv[j]; }
            }
        }
    }
}
__device__ __forceinline__ void p_gla_b(Frame& F) {
    const int lane = F.lane, wave = F.wave, c = lane & 31, hi = lane >> 5;
    LAS float* stg = (LAS float*)(F.lds + wave * 8704);
    for (int ug = blockIdx.x; ug < 256; ug += F.G) {
        const int u = ug * 4 + (wave >> 1), ct = wave & 1;
        const int n = u & 127, bh = u >> 7, b = bh >> 2, h = bh & 3;
        const size_t row0 = (size_t)b * SEQ + n * 64;
        f32x16 acc[4];
        { const float* oi = F_GO + ((size_t)u * 8 + ct) * 1024 + lane * 4;
#pragma unroll
          for (int et = 0; et < 4; ++et)
#pragma unroll
              for (int i4 = 0; i4 < 4; ++i4) { const f32x4 v = *(const GAS f32x4*)(oi + et * 2048 + i4 * 256); acc[et][4 * i4] = v.x; acc[et][4 * i4 + 1] = v.y; acc[et][4 * i4 + 2] = v.z; acc[et][4 * i4 + 3] = v.w; } }
        bf16x8 qf[4];
        { const bf16* qp = F_PROJ + (row0 + 32 * ct + c) * N0 + P0_AQ + h * 64 + 8 * hi;
#pragma unroll
          for (int ks = 0; ks < 4; ++ks) qf[ks] = *(const GAS bf16x8*)(qp + 16 * ks); }
        { const bf16* sp = F_ST + (size_t)u * 8192 + c * 64 + 8 * hi;
#pragma unroll
          for (int et = 0; et < 4; ++et)
#pragma unroll
              for (int ks = 0; ks < 4; ++ks) { const bf16x8 A = *(const GAS bf16x8*)(sp + (32 * et) * 64 + 16 * ks); acc[et] = MFMA32(A, qf[ks], acc[et]); } }
        float ss = 0.f;
#pragma unroll
        for (int et = 0; et < 4; ++et)
#pragma unroll
            for (int r = 0; r < 16; ++r) ss += acc[et][r] * acc[et][r];
        ss += __shfl_xor(ss, 32);
        const float rs = 1.0f / sqrtf(ss * (1.0f / 128.f) + EPS);
#pragma unroll
        for (int half = 0; half < 2; ++half) {
#pragma unroll
            for (int et2 = 0; et2 < 2; ++et2)
#pragma unroll
                for (int g4 = 0; g4 < 4; ++g4) { const int et = half * 2 + et2; f32x4 v; v.x = acc[et][4 * g4] * rs; v.y = acc[et][4 * g4 + 1] * rs; v.z = acc[et][4 * g4 + 2] * rs; v.w = acc[et][4 * g4 + 3] * rs;
                    *(LAS f32x4*)(stg + c * 68 + et2 * 32 + 8 * g4 + 4 * hi) = v; }
            LDS_WAIT(); asm volatile("" ::: "memory");
#pragma unroll
            for (int i = 0; i < 8; ++i) {
                const int rr = i * 4 + (lane >> 4), ch = lane & 15, e = half * 64 + ch * 4;
                const f32x4 v = *(const LAS f32x4*)(stg + rr * 68 + ch * 4);
                const size_t grow = row0 + 32 * ct + rr;
                const v2u gg = *(const GAS v2u*)(F_PROJ + grow * N0 + P0_AG + h * 128 + e);
                const f32x4 gn = *(const GAS f32x4*)(F_gla_gain + e);
                v2u ov; ov.x = cvtpk(v.x * gn.x * silu_f(bflo(gg.x)), v.y * gn.y * silu_f(bfhi(gg.x))); ov.y = cvtpk(v.z * gn.z * silu_f(bflo(gg.y)), v.w * gn.w * silu_f(bfhi(gg.y)));
                *(GAS v2u*)(F_MIX + grow * DM + h * 128 + e) = ov;
            }
            LDS_WAIT(); asm volatile("" ::: "memory");
        }
    }
}
constexpr int EX_BIAS = 132096, EX_CNT = 134144, EX_BASE = 134272, EX_TAB = 134400;
constexpr int MB_K = 0, MB_V = 65536;
__device__ __forceinline__ int offb(int row, int ch) { return 256 * row + 16 * (ch ^ (((row & 3) << 2) | ((row >> 2) & 3))); }
__device__ __forceinline__ void top3_ins(float v, int i, float& v1, int& i1, float& v2, int& i2, float& v3, int& i3) {
    const bool g1 = v > v1, g2 = v > v2, g3 = v > v3;
    v3 = g2 ? v2 : (g3 ? v : v3); i3 = g2 ? i2 : (g3 ? i : i3);
    v2 = g1 ? v1 : (g2 ? v : v2); i2 = g1 ? i1 : (g2 ? i : i2);
    v1 = g1 ? v : v1; i1 = g1 ? i : i1;
}
template <int NT>
__device__ __forceinline__ void moba_softmax_pv(f32x16 (&st)[NT], int ntv, float& m, float& l, f32x16 (&o)[4], LAS unsigned char* vimg, int kt_base, int lane) {
    const int hi = lane >> 5, tq = (lane & 15) >> 2, tp = lane & 3, tblk = (lane >> 4) & 1;
    float mx = -INFINITY;
#pragma unroll
    for (int kk = 0; kk < NT; ++kk)
#pragma unroll
        for (int r = 0; r < 16; ++r) mx = fmaxf(mx, st[kk][r]);
    mx = fmaxf(mx, __shfl_xor(mx, 32));
    const float mn = fmaxf(m, mx), f = ex2(m - mn);
    m = mn; l *= f;
#pragma unroll
    for (int dt = 0; dt < 4; ++dt)
#pragma unroll
        for (int r = 0; r < 16; ++r) o[dt][r] *= f;
    float ls = 0.f;
#pragma unroll
    for (int kk = 0; kk < NT; ++kk)
#pragma unroll
        for (int r = 0; r < 16; ++r) { const float p = ex2(st[kk][r] - mn); st[kk][r] = p; ls += p; }
    l += ls;
#pragma unroll
    for (int kk = 0; kk < NT; ++kk) {
        if (kk < ntv) {
#pragma unroll
            for (int s2 = 0; s2 < 2; ++s2) {
                const bf16x8 pf = pack8(st[kk], s2);
                const int vr = 32 * (kt_base + kk) + 16 * s2 + 4 * hi + tq;
#pragma unroll
                for (int dt = 0; dt < 4; ++dt) {
                    const int ch = 4 * dt + 2 * tblk + (tp >> 1);
                    const v4i16_t lo = tr_read(vimg + offb(vr, ch) + 8 * (tp & 1));
                    const v4i16_t hh = tr_read(vimg + offb(vr + 8, ch) + 8 * (tp & 1));
                    o[dt] = MFMA32(join4(lo, hh), pf, o[dt]);
                }
                __builtin_amdgcn_sched_barrier(0);
            }
        }
    }
}
__device__ __forceinline__ void moba_stage_kv(Frame& F, int b, int kvh, int blk, int nrows) {
    for (int idx = F.tid; idx < nrows * 16; idx += NTHR) {
        const int r = idx >> 4, ch = idx & 15;
        const bf16* src = F_PROJ + ((size_t)b * SEQ + blk * 256 + r) * N1 + kvh * 128 + ch * 8;
        const v4u kk = *(const GAS v4u*)(src + P1_CK), vv = *(const GAS v4u*)(src + P1_CV);
        *(LAS v4u*)(F.lds + MB_K + offb(r, ch)) = kk;
        *(LAS v4u*)(F.lds + MB_V + offb(r, ch)) = vv;
    }
}
__device__ __forceinline__ bf16* moba_po(Frame& F, int slot) { return (bf16*)(F.ws + (slot == 0 ? WS_PO0 : (slot == 1 ? WS_PO1 : WS_PO2))); }

__device__ __forceinline__ void p_moba_sel_own(Frame& F) {
    const int tid = F.tid, lane = F.lane, wave = F.wave, c = lane & 31, hi = lane >> 5;
    LAS float* biasL = (LAS float*)(F.lds + EX_BIAS);
    LAS unsigned* cntL = (LAS unsigned*)(F.lds + EX_CNT);
    LAS unsigned* baseL = (LAS unsigned*)(F.lds + EX_BASE);
    unsigned* CNT = (unsigned*)(F.ws + WS_CTL) + CW_CNT;
    unsigned* FARL = (unsigned*)(F.ws + WS_FARL);
    unsigned* ADJL = (unsigned*)(F.ws + WS_ADJL);
    f32x2_t* ML = (f32x2_t*)(F.ws + WS_ML);
    const float* KPART = (const float*)(F.ws + WS_KPART);
    constexpr int KMHI = 0, KMLO = 8192;
    for (int wp = blockIdx.x; wp < 256; wp += F.G) {
        const int bk = wp >> 6, n0 = (wp >> 1) & 31, psel = wp & 1, b = bk >> 1, kvh = bk & 1;
        const int g = wave >> 1, th = wave & 1, head = kvh * 4 + g;
        __syncthreads();
        biasL[tid] = F_rel_bias[t5_bucket(tid & 127) * 8 + kvh * 4 + (tid >> 7)] * LOG2E;
#pragma unroll
        for (int i = 0; i < 8; ++i) {
            const int idx = tid + NTHR * i, n = idx >> 7, d = idx & 127;
            float km = 0.f;
            if (n < n0) { const float* kp = KPART + ((size_t)(b * 32 + n) * 2) * 256 + kvh * 128 + d; km = (kp[0] + kp[256]) * (1.0f / 256.f); }
            const unsigned h16 = f2bf(km); const float lo = km - bf2f((bf16)h16);
            const int o = offb(n, d >> 3) + (d & 7) * 2;
            *(LAS bf16*)(F.lds + KMHI + o) = (bf16)h16; *(LAS bf16*)(F.lds + KMLO + o) = (bf16)f2bf(lo);
        }
        if (tid < 64) cntL[tid] = 0u;
        __syncthreads();
#pragma unroll 1
        for (int ui = 0; ui < 2; ++ui) {
            const int cq = ui == 0 ? (psel ? 1 : 0) : (psel ? 2 : 3);
            const int t = n0 * 256 + 64 * cq + 32 * th + c;
            const size_t row = (size_t)b * SEQ + t;
            float v1 = -INFINITY, v2 = -INFINITY, v3 = -INFINITY; int i1 = -1, i2 = -1, i3 = -1;
            if (n0 > 0) {
                bf16x8 qf[8];
                { const bf16* qp = F_PROJ + row * N1 + P1_CQ + head * 128 + 8 * hi;
#pragma unroll
                  for (int ks = 0; ks < 8; ++ks) qf[ks] = *(const GAS bf16x8*)(qp + 16 * ks); }
                f32x16 gt = {};
#pragma unroll
                for (int ks = 0; ks < 8; ++ks) {
                    const bf16x8 ah = *(const LAS bf16x8*)(F.lds + KMHI + offb(c, 2 * ks + hi)), al = *(const LAS bf16x8*)(F.lds + KMLO + offb(c, 2 * ks + hi));
                    gt = MFMA32(ah, qf[ks], gt); gt = MFMA32(al, qf[ks], gt);
                    if (ks & 1) __builtin_amdgcn_sched_barrier(0);
                }
#pragma unroll
                for (int r = 0; r < 16; ++r) { const int n = crow(r, hi); const float v = n < n0 ? gt[r] : -INFINITY; top3_ins(v, n, v1, i1, v2, i2, v3, i3); }
                const float w1 = __shfl_xor(v1, 32), w2 = __shfl_xor(v2, 32), w3 = __shfl_xor(v3, 32);
                const int j1 = __shfl_xor(i1, 32), j2 = __shfl_xor(i2, 32), j3 = __shfl_xor(i3, 32);
                top3_ins(w1, j1, v1, i1, v2, i2, v3, i3); top3_ins(w2, j2, v1, i1, v2, i2, v3, i3); top3_ins(w3, j3, v1, i1, v2, i2, v3, i3);
                if (v1 == -INFINITY) i1 = -1;
                if (v2 == -INFINITY) i2 = -1;
                if (v3 == -INFINITY) i3 = -1;
            }
            unsigned r1 = 0u, r2 = 0u, r3 = 0u;
            if (hi == 0) {
                if (i1 >= 0) r1 = __hip_atomic_fetch_add(cntL + i1, 1u, __ATOMIC_RELAXED, __HIP_MEMORY_SCOPE_WORKGROUP);
                if (i2 >= 0) r2 = __hip_atomic_fetch_add(cntL + i2, 1u, __ATOMIC_RELAXED, __HIP_MEMORY_SCOPE_WORKGROUP);
                if (i3 >= 0) r3 = __hip_atomic_fetch_add(cntL + i3, 1u, __ATOMIC_RELAXED, __HIP_MEMORY_SCOPE_WORKGROUP);
            }
            __syncthreads();
            if (tid < 32) { const unsigned cn = cntL[tid]; if (cn) baseL[tid] = __hip_atomic_fetch_add(CNT + (bk * 32 + tid) * 2 + (tid == n0 - 1 ? 1 : 0), cn, __ATOMIC_RELAXED, __HIP_MEMORY_SCOPE_AGENT); cntL[tid] = 0u; }
            __syncthreads();
            if (hi == 0) {
                const unsigned ebase = (unsigned)t | ((unsigned)g << 13);
                const f32x2_t dead = {-INFINITY, 0.f};
#pragma unroll
                for (int s = 0; s < 3; ++s) {
                    const int is = s == 0 ? i1 : (s == 1 ? i2 : i3); const unsigned rs = s == 0 ? r1 : (s == 1 ? r2 : r3);
                    if (is >= 0) { unsigned* lst = (is == n0 - 1) ? ADJL + (size_t)(bk * 32 + is) * 1024 : FARL + (size_t)(bk * 32 + is) * 32768; lst[baseL[is] + rs] = ebase | ((unsigned)s << 15); }
                    else ML[(size_t)s * (M * 8) + row * 8 + head] = dead;
                }
            }
        }
        __syncthreads();
        moba_stage_kv(F, b, kvh, n0, psel ? 192 : 256);
        __syncthreads();
#pragma unroll 1
        for (int ui = 0; ui < 2; ++ui) {
            const int cq = ui == 0 ? (psel ? 1 : 0) : (psel ? 2 : 3);
            const int tq0 = 64 * cq + 32 * th, t = n0 * 256 + tq0 + c, nkt = (tq0 >> 5) + 1;
            const size_t row = (size_t)b * SEQ + t;
            bf16x8 qf[8];
            { const bf16* qp = F_PROJ + row * N1 + P1_CQ + head * 128 + 8 * hi;
#pragma unroll
              for (int ks = 0; ks < 8; ++ks) qf[ks] = *(const GAS bf16x8*)(qp + 16 * ks); }
            float m = -INFINITY, l = 0.f; f32x16 o[4]; o[0] = (f32x16){}; o[1] = (f32x16){}; o[2] = (f32x16){}; o[3] = (f32x16){};
#pragma unroll 1
            for (int kp = 0; 2 * kp < nkt; ++kp) {
                const int ntv = (2 * kp + 1 < nkt) ? 2 : 1;
                f32x16 st[2];
#pragma unroll
                for (int kk = 0; kk < 2; ++kk) {
                    f32x16 acc = {};
                    if (kk < ntv) {
                        const int kr = 32 * (2 * kp + kk) + c;
#pragma unroll
                        for (int ks = 0; ks < 8; ++ks) { const bf16x8 kf = *(const LAS bf16x8*)(F.lds + MB_K + offb(kr, 2 * ks + hi)); acc = MFMA32(kf, qf[ks], acc); }
                    }
#pragma unroll
                    for (int r = 0; r < 16; ++r) {
                        const int dist = tq0 + c - 32 * (2 * kp + kk) - crow(r, hi);
                        const int di = dist < 0 ? 0 : (dist > 127 ? 127 : dist);
                        acc[r] = (kk < ntv && dist >= 0) ? acc[r] + biasL[g * 128 + di] : -INFINITY;
                    }
                    st[kk] = acc;
                }
                moba_softmax_pv<2>(st, ntv, m, l, o, F.lds + MB_V, 2 * kp, lane);
            }
            l += __shfl_xor(l, 32);
            const float inv = 1.0f / l;
            bf16* op = F_MIX + row * DM + head * 128 + 4 * hi;
#pragma unroll
            for (int dt = 0; dt < 4; ++dt)
#pragma unroll
                for (int g4 = 0; g4 < 4; ++g4) { v2u w; w.x = cvtpk(o[dt][4 * g4] * inv, o[dt][4 * g4 + 1] * inv); w.y = cvtpk(o[dt][4 * g4 + 2] * inv, o[dt][4 * g4 + 3] * inv); *(GAS v2u*)(op + 32 * dt + 8 * g4) = w; }
            if (hi == 0) { const f32x2_t ml = {m, l}; ML[(size_t)3 * (M * 8) + row * 8 + head] = ml; }
        }
    }
}

__device__ __forceinline__ void p_moba_part(Frame& F) {
    const int tid = F.tid, lane = F.lane, wave = F.wave, c = lane & 31, hi = lane >> 5;
    LAS float* biasL = (LAS float*)(F.lds + EX_BIAS);
    LAS unsigned* tab = (LAS unsigned*)(F.lds + EX_TAB);
    unsigned* CNT = (unsigned*)(F.ws + WS_CTL) + CW_CNT;
    const unsigned* FARL = (const unsigned*)(F.ws + WS_FARL);
    const unsigned* ADJL = (const unsigned*)(F.ws + WS_ADJL);
    f32x2_t* ML = (f32x2_t*)(F.ws + WS_ML);
    __syncthreads();
    if (wave == 0) {
        unsigned n4[4], s = 0u;
#pragma unroll
        for (int i = 0; i < 4; ++i) { const unsigned cn = __hip_atomic_load(CNT + 4 * lane + i, __ATOMIC_RELAXED, __HIP_MEMORY_SCOPE_AGENT); n4[i] = (cn + 255u) >> 8; s += n4[i]; }
        unsigned inc = s;
#pragma unroll
        for (int o = 1; o < 64; o <<= 1) { const unsigned t = __shfl_up(inc, o); if (lane >= o) inc += t; }
        unsigned run = inc - s;
#pragma unroll
        for (int i = 0; i < 4; ++i) { tab[4 * lane + i] = run; run += n4[i]; }
        if (lane == 63) tab[256] = run;
    }
    __syncthreads();
    const unsigned U = tab[256];
    const unsigned u_lo = (unsigned)(((unsigned long long)U * blockIdx.x) / F.G), u_hi = (unsigned)(((unsigned long long)U * (blockIdx.x + 1)) / F.G);
    int L = 0, cur = -1;
    for (unsigned uu = u_lo; uu < u_hi; ++uu) {
        while (tab[L + 1] <= uu) ++L;
        const int chunk = (int)(uu - tab[L]), bkj = L >> 1, adj = L & 1, bk = bkj >> 5, j = bkj & 31, b = bk >> 1, kvh = bk & 1;
        const unsigned cnt = __hip_atomic_load(CNT + L, __ATOMIC_RELAXED, __HIP_MEMORY_SCOPE_AGENT);
        if (bkj != cur) {
            __syncthreads();
            moba_stage_kv(F, b, kvh, j, 256);
            biasL[tid] = F_rel_bias[t5_bucket(tid & 127) * 8 + kvh * 4 + (tid >> 7)] * LOG2E;
            __syncthreads();
            cur = bkj;
        }
        const unsigned* lst = adj ? ADJL + (size_t)bkj * 1024 : FARL + (size_t)bkj * 32768;
        const unsigned idx = (unsigned)chunk * 256u + wave * 32 + c;
        const bool valid = idx < cnt;
        const unsigned e = lst[valid ? idx : cnt - 1u];
        const int t = e & 8191, g = (e >> 13) & 3, slot = (e >> 15) & 3, head = kvh * 4 + g;
        const size_t row = (size_t)b * SEQ + t;
        bf16x8 qf[8];
        { const bf16* qp = F_PROJ + row * N1 + P1_CQ + head * 128 + 8 * hi;
#pragma unroll
          for (int ks = 0; ks < 8; ++ks) qf[ks] = *(const GAS bf16x8*)(qp + 16 * ks); }
        float m = -INFINITY, l = 0.f; f32x16 o[4]; o[0] = (f32x16){}; o[1] = (f32x16){}; o[2] = (f32x16){}; o[3] = (f32x16){};
        const int tq = t & 255;
#pragma unroll 1
        for (int step = 0; step < 4; ++step) {
            f32x16 st[2];
#pragma unroll
            for (int kk = 0; kk < 2; ++kk) {
                f32x16 acc = {};
                const int kr = 32 * (2 * step + kk) + c;
#pragma unroll
                for (int ks = 0; ks < 8; ++ks) { const bf16x8 kf = *(const LAS bf16x8*)(F.lds + MB_K + offb(kr, 2 * ks + hi)); acc = MFMA32(kf, qf[ks], acc); }
                if (adj) {
#pragma unroll
                    for (int r = 0; r < 16; ++r) { const int dist = tq + 256 - 32 * (2 * step + kk) - crow(r, hi); acc[r] += biasL[g * 128 + (dist > 127 ? 127 : dist)]; }
                }
                st[kk] = acc;
            }
            moba_softmax_pv<2>(st, 2, m, l, o, F.lds + MB_V, 2 * step, lane);
        }
        l += __shfl_xor(l, 32);
        if (valid) {
            const float inv = 1.0f / l;
            bf16* op = moba_po(F, slot) + row * DM + head * 128 + 4 * hi;
#pragma unroll
            for (int dt = 0; dt < 4; ++dt)
#pragma unroll
                for (int g4 = 0; g4 < 4; ++g4) { v2u w; w.x = cvtpk(o[dt][4 * g4] * inv, o[dt][4 * g4 + 1] * inv); w.y = cvtpk(o[dt][4 * g4 + 2] * inv, o[dt][4 * g4 + 3] * inv); *(GAS v2u*)(op + 32 * dt + 8 * g4) = w; }
            if (hi == 0) { const f32x2_t ml = {adj ? m : m + F_rel_bias[31 * 8 + head] * LOG2E, l}; ML[(size_t)slot * (M * 8) + row * 8 + head] = ml; }
        }
    }
}

__device__ __forceinline__ void p_moba_merge(Frame& F) {
    const f32x2_t* ML = (const f32x2_t*)(F.ws + WS_ML);
    const int sub = F.tid & 15;
    for (int item = (blockIdx.x * NTHR + F.tid) >> 4; item < M * 8; item += F.G * (NTHR >> 4)) {
        const int row = item >> 3, head = item & 7;
        const size_t off = (size_t)row * DM + head * 128 + sub * 8;
        const f32x2_t a0 = ML[item], a1 = ML[(size_t)(M * 8) + item], a2 = ML[(size_t)2 * (M * 8) + item], a3 = ML[(size_t)3 * (M * 8) + item];
        const float mm = fmaxf(fmaxf(a0.x, a1.x), fmaxf(a2.x, a3.x));
        const float w0 = ex2(a0.x - mm) * a0.y, w1 = ex2(a1.x - mm) * a1.y, w2 = ex2(a2.x - mm) * a2.y, w3 = ex2(a3.x - mm) * a3.y;
        const float inv = 1.0f / (w0 + w1 + w2 + w3);
        float acc[8];
        { const v4u v = *(const GAS v4u*)(F_MIX + off);
          acc[0] = w3 * bflo(v.x); acc[1] = w3 * bfhi(v.x); acc[2] = w3 * bflo(v.y); acc[3] = w3 * bfhi(v.y); acc[4] = w3 * bflo(v.z); acc[5] = w3 * bfhi(v.z); acc[6] = w3 * bflo(v.w); acc[7] = w3 * bfhi(v.w); }
#pragma unroll
        for (int s = 0; s < 3; ++s) {
            const float w = s == 0 ? w0 : (s == 1 ? w1 : w2);
            if (w > 0.f) { const v4u v = *(const GAS v4u*)(moba_po(F, s) + off);
                acc[0] += w * bflo(v.x); acc[1] += w * bfhi(v.x); acc[2] += w * bflo(v.y); acc[3] += w * bfhi(v.y); acc[4] += w * bflo(v.z); acc[5] += w * bfhi(v.z); acc[6] += w * bflo(v.w); acc[7] += w * bfhi(v.w); }
        }
        const v4u gg = *(const GAS v4u*)(F_PROJ + (size_t)row * N1 + P1_CG + head * 128 + sub * 8);
        v4u ov;
        ov.x = cvtpk(acc[0] * inv * silu_f(bflo(gg.x)), acc[1] * inv * silu_f(bfhi(gg.x))); ov.y = cvtpk(acc[2] * inv * silu_f(bflo(gg.y)), acc[3] * inv * silu_f(bfhi(gg.y)));
        ov.z = cvtpk(acc[4] * inv * silu_f(bflo(gg.z)), acc[5] * inv * silu_f(bfhi(gg.z))); ov.w = cvtpk(acc[6] * inv * silu_f(bflo(gg.w)), acc[7] * inv * silu_f(bfhi(gg.w)));
        *(GAS v4u*)(F_MIX + off) = ov;
    }
}
template <int LO, int HI>
__global__ void __launch_bounds__(NTHR, 2) fwd_kernel(Args args) {
    extern __shared__ __attribute__((aligned(16))) unsigned char lds[];
    Frame F;
    F.lds = (LAS unsigned char*)lds;
    F.MISC = (volatile LAS unsigned*)(F.lds + MISC_OFF);
    F.tid = threadIdx.x; F.lane = F.tid & 63; F.wave = __builtin_amdgcn_readfirstlane(F.tid >> 6);
    F.G = gridDim.x; { const int bx = blockIdx.x; F.vcu = (F.G % 8 == 0) ? (bx % 8) * (F.G / 8) + bx / 8 : bx; }
    F.a = &args; F.ws = args.ws; F.out = args.out;
    unsigned char* ws = args.ws;
    for (int u = F.tid; u < (LDS_BYTES - LDSCTL_OFF) / 4; u += NTHR) ((LAS unsigned*)(F.lds + LDSCTL_OFF))[u] = 0u;
    __syncthreads();
    constexpr bool MULTI = (HI - LO) > 1;
    XcdBarrier bar; bar.bar = (unsigned*)(ws + WS_CTL) + CW_BAR; bar.x = 0; bar.st = nullptr;
    if (MULTI) bar = xcd_barrier_post((unsigned*)(ws + WS_CTL) + CW_BAR, F.MISC + 8);
#define IN(k) (LO <= (k) && (k) < HI)
#define SEAM(k) do { if (IN(k) && IN((k) + 1)) xcd_barrier(bar); } while (0)

    if constexpr (IN(0)) { PHASE_ENTER(); p0_prologue(F); SEAM(0); }
    if constexpr (IN(1)) { PHASE_ENTER();
        pg8::Gemm g{F_XN, F_WT0, M, N0, DM}; pg8::StaticOrder S; S.init(M, N0, F.G, (int)blockIdx.x);
        pg8::EpiProj E{F_PROJ, N0, 0x001u, 0.125f, 0x0C0u, 0.125f * LOG2E};
        pg8::gemm_phase<pg8::EpiProj, pg8::StaticOrder, true, true>(F.lds, g, S, E);
        SEAM(1);
    }
    if constexpr (IN(2)) { PHASE_ENTER(); p_gla_a(F); SEAM(2); }
    if constexpr (IN(3)) { PHASE_ENTER(); p_gla_scan(F); p_swa(F); SEAM(3); }
    if constexpr (IN(4)) { PHASE_ENTER(); p_gla_b(F); SEAM(4); }
    if constexpr (IN(5)) { PHASE_ENTER();
        pg8::Gemm g{F_MIX, F_WTO0, M, DM, DM}; pg8::StaticOrder S; S.init(M, DM, F.G, (int)blockIdx.x);
        pg8::EpiRes E{F_x, F.out, DM};
        pg8::gemm_phase<pg8::EpiRes, pg8::StaticOrder, false, true>(F.lds, g, S, E);
        SEAM(5);
    }
    if constexpr (IN(6)) { PHASE_ENTER(); p_rms_rows_bf16(F, F.out, F_norm_gain + DM, F_XN); SEAM(6); }
    if constexpr (IN(7)) { PHASE_ENTER();
        pg8::Gemm g{F_XN, F_WT1, M, N1, DM}; pg8::StaticOrder S; S.init(M, N1, F.G, (int)blockIdx.x);
        pg8::EpiProjK E{F_PROJ, N1, 0x00Fu, 0.08838834764831845f * LOG2E, (float*)(F.ws + WS_KPART), 4};
        pg8::gemm_phase<pg8::EpiProjK, pg8::StaticOrder, true, true>(F.lds, g, S, E);
        SEAM(7);
    }
    if constexpr (IN(8)) { PHASE_ENTER(); p_moba_sel_own(F); SEAM(8); }
    if constexpr (IN(9)) { PHASE_ENTER(); p_moba_part(F); SEAM(9); }
    if constexpr (IN(10)) { PHASE_ENTER(); p_moba_merge(F); SEAM(10); }
    if constexpr (IN(11)) { PHASE_ENTER();
        pg8::Gemm g{F_MIX, F_WTO1, M, DM, DM}; pg8::StaticOrder S; S.init(M, DM, F.G, (int)blockIdx.x);
        pg8::EpiRes E{F.out, F.out, DM};
        pg8::gemm_phase<pg8::EpiRes, pg8::StaticOrder, false, true>(F.lds, g, S, E);
        SEAM(11);
    }
    if constexpr (IN(12)) { PHASE_ENTER(); p_rms_rows_f32_inplace(F, F.out, F_final_gain); }
#undef IN
#undef SEAM
}

template <int LO, int HI>
static void launch_range(const Args& a, int grid, hipStream_t stream) {
    static bool attr_done = false;
    if (!attr_done) { (void)hipFuncSetAttribute((const void*)fwd_kernel<LO, HI>, hipFuncAttributeMaxDynamicSharedMemorySize, LDS_BYTES); attr_done = true; }
    hipLaunchKernelGGL((fwd_kernel<LO, HI>), dim3(grid), dim3(NTHR), LDS_BYTES, stream, a);
}
#ifndef ONE_LAUNCH
#define ONE_LAUNCH 1
#endif
extern "C" void kernel_launch(void* const* d_in, const int* in_sizes, int n_in, void* d_out, int out_size, void* d_ws, size_t ws_size, hipStream_t stream) {
    static int grid = 0;
    if (grid == 0) {
        int dev = 0, cus = 0;
        if (hipGetDevice(&dev) != hipSuccess || hipDeviceGetAttribute(&cus, hipDeviceAttributeMultiprocessorCount, dev) != hipSuccess) { fprintf(stderr, "kernel_launch: device query failed\n"); grid = -1; return; }
        if (n_in != 12 || ws_size < WS_END) { fprintf(stderr, "kernel_launch: unexpected inputs / workspace\n"); grid = -1; return; }
        grid = cus;
    }
    if (grid < 0) return;
    (void)hipMemsetAsync((char*)d_ws + WS_CTL, 0, CTL_ZERO_BYTES, stream);
    Args a{};
    for (int i = 0; i < 12; ++i) a.in[i] = (const float*)d_in[i];
    a.out = (float*)d_out; a.ws = (unsigned char*)d_ws;
#if ONE_LAUNCH
    launch_range<0, NPHASE>(a, grid, stream);
#else
    launch_range<0, 1>(a, grid, stream); launch_range<1, 2>(a, grid, stream); launch_range<2, 3>(a, grid, stream); launch_range<3, 4>(a, grid, stream);
    launch_range<4, 5>(a, grid, stream); launch_range<5, 6>(a, grid, stream); launch_range<6, 7>(a, grid, stream); launch_range<7, 8>(a, grid, stream);
    launch_range<8, 9>(a, grid, stream); launch_range<9, 10>(a, grid, stream); launch_range<10, 11>(a, grid, stream); launch_range<11, 12>(a, grid, stream);
#endif
}
```
